# Optimizing an MI355X kernel written in HIP

```python
import jax, jax.numpy as jnp
from jax import lax
import numpy as np

D_MODEL = 1024
BATCH = 4
SEQ = 8192
DEPTH = 4

N_MIXERS = 4
N_META = 16
Q_BLOCK = 128
EPS = 1e-6
POOL_WINDOWS = (2, 4, 8, 16)
N_POOL_GROUPS = len(POOL_WINDOWS)
POOL_GROUP = D_MODEL // N_POOL_GROUPS
N_HEADS = 16
HEAD_DIM = D_MODEL // N_HEADS
MLA_HEADS = 16
MLA_Q_RANK = 384
MLA_KV_RANK = 256
MLA_NOPE = 64
MLA_ROPE = 32
MLA_V = 64
ROPE_THETA = 10000.0
D_FF = ((-(-8 * D_MODEL // 3) + 255) // 256) * 256

kernel_name = "hybrid_pool_sb_mla_fox_trunk"


def _n_layers_of(m):
    return len(range(m, DEPTH, N_MIXERS))


def rmsnorm(x, g):
    xf = x.astype(jnp.float32)
    y = xf * lax.rsqrt(jnp.mean(xf * xf, axis=-1, keepdims=True) + EPS)
    return (y * g.astype(jnp.float32)).astype(x.dtype)


def swiglu(h, w_gate, w_up, w_down):
    return (jax.nn.silu(h @ w_gate) * (h @ w_up)) @ w_down


def sweep_queries(attend, q_parts, kv_parts):
    L = q_parts[0].shape[1]
    pos = jnp.arange(L)
    meta_out = attend(tuple(a[:, :N_META] for a in q_parts), pos[:N_META],
                      tuple(a[:, :N_META] for a in kv_parts), pos[:N_META])
    n_blk = (L - N_META) // Q_BLOCK

    def body(i):
        start = N_META + i * Q_BLOCK
        qs = tuple(lax.dynamic_slice_in_dim(a, start, Q_BLOCK, axis=1) for a in q_parts)
        return attend(qs, start + jnp.arange(Q_BLOCK), kv_parts, pos)

    out = lax.map(body, jnp.arange(n_blk))
    B = out.shape[1]
    out = jnp.moveaxis(out, 0, 1).reshape((B, n_blk * Q_BLOCK) + out.shape[3:])
    return jnp.concatenate([meta_out, out], axis=1)


def softmax_block(q, k, v, qpos, kpos, scale, q_decay=None, k_decay=None):
    s = jnp.einsum('bqhd,bkhd->bhqk', q, k).astype(jnp.float32) * scale
    if q_decay is not None:
        s = s + (jnp.transpose(q_decay, (0, 2, 1))[:, :, :, None]
                 - jnp.transpose(k_decay, (0, 2, 1))[:, :, None, :]).astype(jnp.float32)
    mask = kpos[None, :] <= qpos[:, None]
    s = jnp.where(mask, s, jnp.finfo(jnp.float32).min)
    p = jax.nn.softmax(s, axis=-1)
    return jnp.einsum('bhqk,bkhd->bqhd', p.astype(v.dtype), v)


def pool_mixer(h, w, scale):
    B, L, _ = h.shape
    hf = h.astype(jnp.float32)
    pos = jnp.arange(L)
    outs = []
    for g, win in enumerate(POOL_WINDOWS):
        xg = hf[..., g * POOL_GROUP:(g + 1) * POOL_GROUP]
        cs = jnp.cumsum(xg, axis=1)
        lag = jnp.pad(cs[:, :-win], ((0, 0), (win, 0), (0, 0)))
        cnt = jnp.minimum(pos + 1, win).astype(jnp.float32)[None, :, None]
        outs.append((cs - lag) / cnt - xg)
    pooled = jnp.stack(outs, axis=2).astype(h.dtype)
    mixed = jnp.einsum('blgc,gcd->blgd', pooled, w).reshape(B, L, D_MODEL)
    return mixed * scale


def _sb_attend(qs, qpos, kvs, kpos):
    (q,) = qs
    k, v = kvs
    z = jnp.einsum('bqhd,bkhd->bhqk', q, k).astype(jnp.float32) * (HEAD_DIM ** -0.5)
    mask = kpos[None, :] < qpos[:, None]
    log_keep = jnp.where(mask, jax.nn.log_sigmoid(-z), 0.0)
    later = lax.cumsum(log_keep, axis=3, reverse=True) - log_keep
    a = jnp.where(mask, jnp.exp(jax.nn.log_sigmoid(z) + later), 0.0)
    return jnp.einsum('bhqk,bkhd->bqhd', a.astype(v.dtype), v)


def sb_mixer(h, w_qkv, w_o):
    B, L, _ = h.shape
    qkv = (h @ w_qkv).reshape(B, L, 3, N_HEADS, HEAD_DIM)
    q, k, v = qkv[:, :, 0], qkv[:, :, 1], qkv[:, :, 2]
    o = sweep_queries(_sb_attend, (q,), (k, v))
    return o.reshape(B, L, N_HEADS * HEAD_DIM) @ w_o


def _rope(x, cos, sin):
    xf = x.astype(jnp.float32)
    half = xf.shape[-1] // 2
    x1, x2 = xf[..., :half], xf[..., half:]
    return jnp.concatenate([x1 * cos - x2 * sin, x2 * cos + x1 * sin], axis=-1).astype(x.dtype)


def _mla_attend(qs, qpos, kvs, kpos):
    (q,) = qs
    k, v = kvs
    return softmax_block(q, k, v, qpos, kpos, (MLA_NOPE + MLA_ROPE) ** -0.5)


def mla_mixer(h, w_down, q_norm, kv_norm, w_uq, w_ukv, w_o):
    B, L, _ = h.shape
    down = h @ w_down
    c_q = rmsnorm(down[..., :MLA_Q_RANK], q_norm)
    c_kv = rmsnorm(down[..., MLA_Q_RANK:MLA_Q_RANK + MLA_KV_RANK], kv_norm)
    k_rope = down[..., MLA_Q_RANK + MLA_KV_RANK:]
    q = (c_q @ w_uq).reshape(B, L, MLA_HEADS, MLA_NOPE + MLA_ROPE)
    kv = (c_kv @ w_ukv).reshape(B, L, MLA_HEADS, MLA_NOPE + MLA_V)
    q_nope, q_rope = q[..., :MLA_NOPE], q[..., MLA_NOPE:]
    k_nope, v = kv[..., :MLA_NOPE], kv[..., MLA_NOPE:]
    inv = ROPE_THETA ** (-jnp.arange(0, MLA_ROPE, 2, dtype=jnp.float32) / MLA_ROPE)
    ang = jnp.arange(L, dtype=jnp.float32)[:, None] * inv[None, :]
    cos, sin = jnp.cos(ang), jnp.sin(ang)
    q_rope = _rope(q_rope, cos[:, None, :], sin[:, None, :])
    k_rope = _rope(k_rope, cos, sin)
    q = jnp.concatenate([q_nope, q_rope], axis=-1)
    k = jnp.concatenate([k_nope, jnp.broadcast_to(k_rope[:, :, None, :], (B, L, MLA_HEADS, MLA_ROPE))], axis=-1)
    o = sweep_queries(_mla_attend, (q,), (k, v))
    return o.reshape(B, L, MLA_HEADS * MLA_V) @ w_o


def _fox_attend(qs, qpos, kvs, kpos):
    q, fq = qs
    k, v, fk = kvs
    return softmax_block(q, k, v, qpos, kpos, HEAD_DIM ** -0.5, fq, fk)


def fox_mixer(h, w_qkvf, b_f, w_o):
    B, L, _ = h.shape
    proj = h @ w_qkvf
    qkv = proj[..., :3 * N_HEADS * HEAD_DIM].reshape(B, L, 3, N_HEADS, HEAD_DIM)
    q, k, v = qkv[:, :, 0], qkv[:, :, 1], qkv[:, :, 2]
    f_logit = proj[..., 3 * N_HEADS * HEAD_DIM:].astype(jnp.float32) + b_f.astype(jnp.float32)
    F = jnp.cumsum(jax.nn.log_sigmoid(f_logit), axis=1)
    o = sweep_queries(_fox_attend, (q, F), (k, v, F))
    return o.reshape(B, L, N_HEADS * HEAD_DIM) @ w_o


def setup_inputs(seed: int = 0) -> dict:
    key = jax.random.key(seed)
    ks = jax.random.split(key, 24)
    f32 = jnp.float32

    def w(k, shape, fan_in):
        return jax.random.normal(k, shape, f32) * (fan_in ** -0.5)

    def gain(k, shape):
        return 1.0 + 0.02 * jax.random.normal(k, shape, f32)

    nA, nB, nC, nD = (_n_layers_of(m) for m in range(N_MIXERS))
    D = D_MODEL
    return {
        "x": jax.random.normal(ks[0], (BATCH, SEQ, D), f32),
        "meta": jax.random.normal(ks[1], (N_META, D), f32),
        "norm_mix": gain(ks[2], (DEPTH, D)),
        "norm_ffn": gain(ks[3], (DEPTH, D)),
        "pool_w": w(ks[4], (nA, N_POOL_GROUPS, POOL_GROUP, POOL_GROUP), POOL_GROUP),
        "pool_scale": gain(ks[5], (nA, D)),
        "sb_w_qkv": w(ks[6], (nB, D, 3 * N_HEADS * HEAD_DIM), D),
        "sb_w_o": w(ks[7], (nB, N_HEADS * HEAD_DIM, D), N_HEADS * HEAD_DIM),
        "mla_w_down": w(ks[8], (nC, D, MLA_Q_RANK + MLA_KV_RANK + MLA_ROPE), D),
        "mla_q_norm": gain(ks[9], (nC, MLA_Q_RANK)),
        "mla_kv_norm": gain(ks[10], (nC, MLA_KV_RANK)),
        "mla_w_uq": w(ks[11], (nC, MLA_Q_RANK, MLA_HEADS * (MLA_NOPE + MLA_ROPE)), MLA_Q_RANK),
        "mla_w_ukv": w(ks[12], (nC, MLA_KV_RANK, MLA_HEADS * (MLA_NOPE + MLA_V)), MLA_KV_RANK),
        "mla_w_o": w(ks[13], (nC, MLA_HEADS * MLA_V, D), MLA_HEADS * MLA_V),
        "fox_w_qkvf": w(ks[14], (nD, D, 3 * N_HEADS * HEAD_DIM + N_HEADS), D),
        "fox_b_f": 2.0 + 0.5 * jax.random.normal(ks[15], (nD, N_HEADS), f32),
        "fox_w_o": w(ks[16], (nD, N_HEADS * HEAD_DIM, D), N_HEADS * HEAD_DIM),
        "ffn_w_gate": w(ks[17], (DEPTH, D, D_FF), D),
        "ffn_w_up": w(ks[18], (DEPTH, D, D_FF), D),
        "ffn_w_down": w(ks[19], (DEPTH, D_FF, D), D_FF),
        "final_norm": gain(ks[20], (D,)),
    }


def reference(x, meta, norm_mix, norm_ffn, pool_w, pool_scale, sb_w_qkv, sb_w_o,
              mla_w_down, mla_q_norm, mla_kv_norm, mla_w_uq, mla_w_ukv, mla_w_o,
              fox_w_qkvf, fox_b_f, fox_w_o, ffn_w_gate, ffn_w_up, ffn_w_down, final_norm):
    B = x.shape[0]
    meta_b = jnp.broadcast_to(meta[None].astype(x.dtype), (B, N_META, D_MODEL))
    h = jnp.concatenate([meta_b, x], axis=1)
    for i in range(DEPTH):
        m, j = i % N_MIXERS, i // N_MIXERS
        a = rmsnorm(h, norm_mix[i])
        if m == 0:
            mix = pool_mixer(a, pool_w[j], pool_scale[j])
        elif m == 1:
            mix = sb_mixer(a, sb_w_qkv[j], sb_w_o[j])
        elif m == 2:
            mix = mla_mixer(a, mla_w_down[j], mla_q_norm[j], mla_kv_norm[j],
                            mla_w_uq[j], mla_w_ukv[j], mla_w_o[j])
        else:
            mix = fox_mixer(a, fox_w_qkvf[j], fox_b_f[j], fox_w_o[j])
        h = h + mix
        h = h + swiglu(rmsnorm(h, norm_ffn[i]), ffn_w_gate[i], ffn_w_up[i], ffn_w_down[i])
    h = rmsnorm(h, final_norm)
    return h[:, N_META:]
```

```cpp
#include <hip/hip_runtime.h>
#include <hip/hip_cooperative_groups.h>
#include <stdint.h>
#include <cstdio>
#include <cstring>
#include <type_traits>
namespace cg = cooperative_groups;

typedef unsigned short bf16_t;
typedef short bf16x8 __attribute__((ext_vector_type(8)));
typedef float f32x16 __attribute__((ext_vector_type(16)));
typedef float f32x4 __attribute__((ext_vector_type(4)));
typedef float f32x2 __attribute__((ext_vector_type(2)));
typedef unsigned u32x4 __attribute__((ext_vector_type(4)));
typedef unsigned u32x2 __attribute__((ext_vector_type(2)));
typedef __bf16 bf2_t __attribute__((ext_vector_type(2)));
typedef unsigned long long u64;

#define DI __device__ __forceinline__
#define MFMA32(a, b, c) __builtin_amdgcn_mfma_f32_32x32x16_bf16((a), (b), (c), 0, 0, 0)

constexpr int NB = 4, SEQ = 8192, NMETA = 16, L = SEQ + NMETA  , M = NB * L  ;
constexpr int D = 1024, DFF = 2816, NH = 16;
constexpr int LP = 8256;
constexpr float EPS = 1e-6f;
constexpr int NTHREADS = 256;
constexpr int NPHASE = 22;
#ifndef PROBE_ON
#define PROBE_ON 0
#endif

struct PrepJob {
  const float* src; bf16_t* dst; const float* gain; const float* colscale;
  int K, Njob, Npad, ld_src, ld_dst;
  int sblk, sstride, soff, dblk, dstride, doff;
  int tile_start, ntn;
};
constexpr int NJOBS = 25;

struct Params {
  const float* in[21];
  float* out;
  bf16_t *w_pool, *w_sbqkv, *w_sbo, *w_mdown, *w_muq, *w_mukv, *w_mo, *w_fqkvf, *w_fo, *w_gu, *w_dn;
  float* h; bf16_t* hb; u64* ssq; float* flog; float* Fh; bf16_t* kr; bf16_t* down; bf16_t* R;
  unsigned* counters; unsigned* bar;
  int prep_tiles; int probe; int dryv; int pad1;
  PrepJob jobs[NJOBS];
};

enum { EPI_RESID = 0, EPI_STORE = 1, EPI_SWIGLU = 2 };

struct GemmDesc {
  const bf16_t* A; const bf16_t* Bt;
  int lda, a_cs, ldb, K, N, epi, a_grp;
  const u64* ssq_in; float inv_dim;
  float* h; bf16_t* hb; u64* ssq_out; int c_off;
  bf16_t* d0; int ld0, n0end; bf16_t* d1; int ld1, n1end; bf16_t* vt; int nvend;
  u64* ssq_a; int ssq_a_end; u64* ssq_b; int ssq_b_end;
  float* flog; const float* bfv;
  bf16_t* act;
  unsigned* kmax;
};

DI unsigned pk_bf16(float lo, float hi) {
  f32x2 v = {lo, hi};
  bf2_t b = __builtin_convertvector(v, bf2_t);
  return __builtin_bit_cast(unsigned, b);
}
DI float bf2f(short s) { return __uint_as_float(((unsigned)(unsigned short)s) << 16); }
DI float fexp2(float x) { return __builtin_amdgcn_exp2f(x); }
DI float flog2(float x) { return __builtin_amdgcn_logf(x); }
DI int otid() { int t = threadIdx.x; asm volatile("" : "+v"(t)); return t; }
DI unsigned xb_xcc_id() { return (unsigned)__builtin_amdgcn_s_getreg((3 << 11) | 20) & 0xFu; }
DI float ssq_f(u64 v) { return (float)v * (1.f / 1048576.f); }
DI void ssq_add(u64* p, float part) { atomicAdd(p, (u64)(part * 1048576.f + 0.5f)); }
DI int crow(int i, int h) { return (i & 3) + 8 * (i >> 2) + 4 * h; }

constexpr int LST = 72;
constexpr int TILE_EL = 128 * LST;
constexpr int SMEM_BYTES = 4 * TILE_EL * 2;

template <bool SWAP, bool HALF>
DI void gemm_mainloop(const GemmDesc& d, int m0, int n0, bf16_t* smem, f32x16 (&acc)[2][2], int dry) {
  const int t = otid(), lane = t & 63, w = t >> 6, wm = w >> 1, wn = w & 1, r = lane & 31, hh = lane >> 5;
  const int lrow = t >> 3, lkc = t & 7;
  const bf16_t* ap[4]; const bf16_t* bp[4];
#pragma unroll
  for (int i = 0; i < 4; ++i) {
    int am = m0 + lrow + 32 * i; am = am < M ? am : M - 1;
    ap[i] = d.A + (size_t)am * d.lda + lkc * 8 + (d.a_grp ? (n0 / d.a_grp) * d.a_grp : 0);
    bp[i] = d.Bt + (size_t)(n0 + lrow + 32 * i) * d.ldb + lkc * 8;
  }
#pragma unroll
  for (int a = 0; a < 2; ++a)
#pragma unroll
    for (int b = 0; b < 2; ++b)
#pragma unroll
      for (int i = 0; i < 16; ++i) acc[a][b][i] = 0.f;
  u32x4 ra0[4], rb0[4], ra1[4], rb1[4];
  const int nk = d.K >> 6;
  const int lds_w = lrow * LST + lkc * 8;
  auto gl = [&](u32x4 (&ra)[4], u32x4 (&rb)[4], int ks) {
#pragma unroll
    for (int i = 0; i < 4; ++i) {
      ra[i] = *(const u32x4*)(ap[i] + (size_t)ks * d.a_cs);
      __builtin_amdgcn_sched_barrier(0);
      rb[i] = *(const u32x4*)(bp[i] + (size_t)ks * 64);
      __builtin_amdgcn_sched_barrier(0);
    }
  };
  auto lw = [&](const u32x4 (&ra)[4], const u32x4 (&rb)[4], int buf) {
    bf16_t* An = smem + buf * 2 * TILE_EL + lds_w; bf16_t* Bn = An + TILE_EL;
#pragma unroll
    for (int i = 0; i < 4; ++i) {
      *(u32x4*)(An + 32 * i * LST) = ra[i];
      *(u32x4*)(Bn + 32 * i * LST) = rb[i];
    }
  };
  bf16x8 fa[2][2], fb[2][2];
  auto ldf = [&](int buf, int kk, int set) {
    const bf16_t* Ab = smem + buf * 2 * TILE_EL + ((HALF ? 0 : wm * 64) + r) * LST + 8 * hh + kk * 16;
    const bf16_t* Bb = smem + buf * 2 * TILE_EL + TILE_EL + ((HALF ? w * 32 : wn * 64) + r) * LST + 8 * hh + kk * 16;
#pragma unroll
    for (int i = 0; i < 2; ++i) { fa[set][i] = *(const bf16x8*)(Ab + i * 32 * LST); if (!HALF || i == 0) fb[set][i] = *(const bf16x8*)(Bb + i * 32 * LST); }
  };
  auto mma = [&](int set) {
#pragma unroll
    for (int a = 0; a < 2; ++a)
#pragma unroll
      for (int b = 0; b < (HALF ? 1 : 2); ++b) {
        if (SWAP) acc[a][b] = MFMA32(fb[set][b], fa[set][a], acc[a][b]);
        else      acc[a][b] = MFMA32(fa[set][a], fb[set][b], acc[a][b]);
      }
  };
#define SB_ __builtin_amdgcn_sched_barrier(0)
  auto stage = [&](int cur, u32x4 (&ran)[4], u32x4 (&rbn)[4], int ks) {
    ldf(cur, 1, 1); SB_;
    mma(0); SB_;
    ldf(cur, 2, 0); SB_;
    lw(ran, rbn, cur ^ 1);
    gl(ran, rbn, (ks + 3 < nk) ? ks + 3 : nk - 1);
    SB_;
    mma(1); SB_;
    __syncthreads();
    ldf(cur, 3, 1); SB_;
    mma(0); SB_;
    ldf(cur ^ 1, 0, 0);
    SB_;
    mma(1); SB_;
    __syncthreads();
  };
  gl(ra0, rb0, 0);
  gl(ra1, rb1, 1);
  lw(ra0, rb0, 0);
  gl(ra0, rb0, 2);
  __syncthreads();
  ldf(0, 0, 0);
#pragma unroll 1
  for (int ks = 0; ks < nk; ks += 2) {
    stage(0, ra1, rb1, ks);
    stage(1, ra0, rb0, ks + 1);
  }
#undef SB_
}

constexpr int CS = 132;

DI float hsum32(float v) {
#pragma unroll
  for (int o = 16; o > 0; o >>= 1) v += __shfl_xor(v, o);
  return v;
}

DI void gemm_tile(const GemmDesc& d, int m0, int n0, bf16_t* smem, int dry) {
  const int t = otid(), lane = t & 63, w = t >> 6, wm = w >> 1, wn = w & 1, r = lane & 31, hh = lane >> 5;
  float* Ct = (float*)smem;
  f32x16 acc[2][2];
  const bool vtile = (d.epi == EPI_STORE) && (n0 >= d.n1end) && (n0 < d.nvend);
  float* rs_s = (float*)((unsigned char*)smem + 128 * CS * 4);
  u64 myss = 0ull;
  if (d.ssq_in && t < 128) { const int mr = (m0 + t) < M ? (m0 + t) : M - 1; myss = d.ssq_in[mr]; }
  if (vtile) {
    gemm_mainloop<false, false>(d, m0, n0, smem, acc, dry);
    if (dry) return;
    if (t < 128) rs_s[t] = rsqrtf(ssq_f(myss) * d.inv_dim + EPS);
#pragma unroll
    for (int a = 0; a < 2; ++a)
#pragma unroll
      for (int g = 0; g < 4; ++g) {
        const int ml = wm * 64 + a * 32 + 8 * g + 4 * hh;
#pragma unroll
        for (int b = 0; b < 2; ++b) {
          f32x4 o;
#pragma unroll
          for (int j = 0; j < 4; ++j) o[j] = acc[a][b][4 * g + j];
          *(f32x4*)(Ct + (wn * 64 + b * 32 + r) * CS + ml) = o;
        }
      }
    __syncthreads();
#pragma unroll 4
    for (int pass = 0; pass < 16; ++pass) {
      const int nl = pass * 8 + (t >> 5), c4 = t & 31, mb = m0 + c4 * 4;
      if (mb < M) {
        const f32x4 v = *(const f32x4*)(Ct + nl * CS + c4 * 4);
        const f32x4 rv = *(const f32x4*)(rs_s + c4 * 4);
        const int nv = n0 - d.n1end + nl, head = nv >> 6, dd = nv & 63;
        const int bb = mb / L, pos = mb - bb * L;
        u32x2 o; o[0] = pk_bf16(v[0] * rv[0], v[1] * rv[1]); o[1] = pk_bf16(v[2] * rv[2], v[3] * rv[3]);
        *(u32x2*)(d.vt + ((size_t)((bb * NH + head) * 64 + dd)) * LP + pos) = o;
      }
    }
    __syncthreads();
    return;
  }
  const bool half = false;
  if (half) gemm_mainloop<true, true>(d, m0, n0, smem, acc, dry);
  else      gemm_mainloop<true, false>(d, m0, n0, smem, acc, dry);
  if (dry) return;
  u32x2 hpre[16];
  if (d.epi == EPI_RESID) {
#pragma unroll
    for (int pass = 0; pass < 16; ++pass) {
      int m = m0 + pass * 8 + (t >> 5); m = m < M ? m : M - 1;
      hpre[pass] = *(const u32x2*)(d.hb + (size_t)m * D + d.c_off + n0 + (t & 31) * 4);
    }
  } else if (t < 128) {
    rs_s[t] = rsqrtf(ssq_f(myss) * d.inv_dim + EPS);
  }
  if (half) {
#pragma unroll
    for (int a = 0; a < 2; ++a)
#pragma unroll
      for (int g = 0; g < 4; ++g) {
        f32x4 o;
#pragma unroll
        for (int j = 0; j < 4; ++j) o[j] = acc[a][0][4 * g + j];
        *(f32x4*)(Ct + (a * 32 + r) * CS + w * 32 + 8 * g + 4 * hh) = o;
      }
  } else {
#pragma unroll
    for (int a = 0; a < 2; ++a)
#pragma unroll
      for (int b = 0; b < 2; ++b)
#pragma unroll
        for (int g = 0; g < 4; ++g) {
          f32x4 o;
#pragma unroll
          for (int j = 0; j < 4; ++j) o[j] = acc[a][b][4 * g + j];
          *(f32x4*)(Ct + (wm * 64 + a * 32 + r) * CS + wn * 64 + b * 32 + 8 * g + 4 * hh) = o;
        }
  }
  __syncthreads();
  if (d.epi == EPI_RESID) {
#pragma unroll
    for (int pass = 0; pass < 16; ++pass) {
      const int row = pass * 8 + (t >> 5), c4 = t & 31, m = m0 + row;
      float part = 0.f;
      if (m < M) {
        const f32x4 v = *(const f32x4*)(Ct + row * CS + c4 * 4);
        const int n = d.c_off + n0 + c4 * 4;
        f32x4 hv;
        hv[0] = __uint_as_float(hpre[pass][0] << 16); hv[1] = __uint_as_float(hpre[pass][0] & 0xffff0000u);
        hv[2] = __uint_as_float(hpre[pass][1] << 16); hv[3] = __uint_as_float(hpre[pass][1] & 0xffff0000u);
#pragma unroll
        for (int j = 0; j < 4; ++j) { hv[j] += v[j]; part += hv[j] * hv[j]; }
        u32x2 o; o[0] = pk_bf16(hv[0], hv[1]); o[1] = pk_bf16(hv[2], hv[3]);
        *(u32x2*)(d.hb + (size_t)m * D + n) = o;
      }
      part = hsum32(part);
      if (c4 == 0 && m < M) ssq_add(d.ssq_out + m, part);
    }
  } else if (d.epi == EPI_SWIGLU) {
#pragma unroll
    for (int pass = 0; pass < 8; ++pass) {
      const int row = pass * 16 + (t >> 4), c4 = t & 15, m = m0 + row;
      if (m < M) {
        const float rs = rs_s[row];
        const int ac = c4 * 4, cb = (ac >> 5) * 64 + (ac & 31);
        const f32x4 gt = *(const f32x4*)(Ct + row * CS + cb);
        const f32x4 up = *(const f32x4*)(Ct + row * CS + cb + 32);
        float v[4];
#pragma unroll
        for (int j = 0; j < 4; ++j) {
          const float gg = gt[j] * rs;
          v[j] = gg * __builtin_amdgcn_rcpf(1.f + fexp2(-gg * 1.44269504f)) * (up[j] * rs);
        }
        u32x2 o; o[0] = pk_bf16(v[0], v[1]); o[1] = pk_bf16(v[2], v[3]);
        *(u32x2*)(d.act + (size_t)m * DFF + (n0 >> 1) + ac) = o;
      }
    }
  } else if (n0 < d.n1end) {
    bf16_t* dst; int ld, nb;
    if (n0 < d.n0end) { dst = d.d0; ld = d.ld0; nb = n0; } else { dst = d.d1; ld = d.ld1; nb = n0 - d.n0end; }
    unsigned* kq = (d.kmax && n0 >= d.n0end) ? d.kmax : nullptr;
    const int mlast = (m0 + 127) < M ? (m0 + 127) : M - 1;
    const bool onebatch = (m0 / L) == (mlast / L);
    float kmx = 0.f;
    u64* sq = nullptr;
    if (d.ssq_a) { if (n0 < d.ssq_a_end) sq = d.ssq_a; else if (n0 < d.ssq_b_end) sq = d.ssq_b; }
#pragma unroll
    for (int pass = 0; pass < 16; ++pass) {
      const int row = pass * 8 + (t >> 5), c4 = t & 31, m = m0 + row;
      float part = 0.f, kpart = 0.f;
      if (m < M) {
        const float rs = rs_s[row];
        f32x4 v = *(const f32x4*)(Ct + row * CS + c4 * 4);
#pragma unroll
        for (int j = 0; j < 4; ++j) { v[j] *= rs; part += v[j] * v[j]; }
        u32x2 o; o[0] = pk_bf16(v[0], v[1]); o[1] = pk_bf16(v[2], v[3]);
        *(u32x2*)(dst + (size_t)m * ld + nb + c4 * 4) = o;
        if (kq) {
          const float a0 = __uint_as_float(o[0] << 16), a1 = __uint_as_float(o[0] & 0xffff0000u);
          const float a2 = __uint_as_float(o[1] << 16), a3 = __uint_as_float(o[1] & 0xffff0000u);
          kpart = a0 * a0 + a1 * a1 + a2 * a2 + a3 * a3;
        }
      }
      if (kq) {
        float kpart2 = kpart;
#pragma unroll
        for (int o = 8; o > 0; o >>= 1) kpart2 += __shfl_xor(kpart2, o);
        if (onebatch) kmx = fmaxf(kmx, kpart2);
        else if ((c4 & 15) == 0 && m < M) atomicMax(kq + (m / L) * NH + ((nb + c4 * 4) >> 6), __float_as_uint(kpart2));
      }
      if (sq) {
        part = hsum32(part);
        if (c4 == 0 && m < M) ssq_add(sq + m, part);
      }
    }
    if (kq && onebatch && ((t & 15) == 0)) atomicMax(kq + (m0 / L) * NH + ((nb + (t & 31) * 4) >> 6), __float_as_uint(kmx));
  } else {
#pragma unroll
    for (int pass = 0; pass < 2; ++pass) {
      const int row = pass * 64 + (t >> 2), c4 = t & 3, m = m0 + row;
      if (m < M) {
        const float rs = rs_s[row];
        const f32x4 v = *(const f32x4*)(Ct + row * CS + c4 * 4);
        f32x4 o;
#pragma unroll
        for (int j = 0; j < 4; ++j) {
          const float x = v[j] * rs + d.bfv[c4 * 4 + j];
          o[j] = fminf(x, 0.f) - 0.69314718f * flog2(1.f + fexp2(-fabsf(x) * 1.44269504f));
        }
        *(f32x4*)(d.flog + (size_t)m * 16 + c4 * 4) = o;
      }
    }
  }
  __syncthreads();
}

DI void gemm_phase(const GemmDesc& d, bf16_t* smem, int dry = 0) {
  const int nM = (M + 127) / 128, nN = d.N >> 7;
  const int x = blockIdx.x & 7, slot = blockIdx.x >> 3, nslots = gridDim.x >> 3;
  const int cx = (nM - x + 7) >> 3, total = cx * nN;
  for (int i = slot; i < total; i += nslots) {
    const int g = i / (8 * nN), j = i - g * 8 * nN;
    const int gm = (cx - g * 8) < 8 ? (cx - g * 8) : 8;
    const int mt = (g * 8 + j % gm) * 8 + x, nt = j / gm;
    gemm_tile(d, mt * 128, nt * 128, smem, dry);
  }
}

struct AttnArgs { bf16_t* q; int ldq, hs; const bf16_t* k; const bf16_t* kr; const bf16_t* vt; const float* Fh; unsigned* ctr; const unsigned* kmax; };
constexpr int VST = 68;

template <int MODE>
DI void attn_phase(const AttnArgs& aa, bf16_t* smem, int dry = 0) {
  constexpr int DQK = (MODE == 1) ? 96 : 64, NKS = DQK / 16, KST = DQK + 8;
  constexpr int KCH = (MODE == 1) ? 3 : 2;
  const int t = otid(), lane = t & 63, w = t >> 6, r = lane & 31, hh = lane >> 5;
  bf16_t* Kl = smem;
  bf16_t* Vl = smem + 2 * 64 * KST;
  float* Fl = (float*)(Vl + 2 * 64 * VST);
  int* s_item = (int*)(Fl + 128);
  int* s_flag = s_item + 4;
  const int total = NB * NH * 65;
  const int lkey = t >> 2, lsub = t & 3;
  constexpr float LOG2E = 1.44269504f;
  const float c2 = (MODE == 1 ? 0.10206207f : 0.125f) * LOG2E;

  const int myx = (int)(xb_xcc_id() & 7u);
  int qx = 0;
  for (;;) {
    __syncthreads();
    if (t == 0) {
      int v = -1;
      while (qx < 8) {
        const int xx = (myx + qx) & 7;
        const int got = (int)atomicAdd(aa.ctr + xx, 1u);
        if (got < total / 8) { v = got * 8 + xx; break; }
        ++qx;
      }
      s_item[0] = v; s_item[1] = qx;
    }
    __syncthreads();
    const int enc = s_item[0]; qx = s_item[1];
    if (enc < 0) break;
    const int xx_ = enc & 7, idx = enc >> 3;
    const int qt = 64 - idx % 65, bh = (idx / 65) * 8 + xx_, b = bh >> 4, hd = bh & 15;
    const int q0 = qt * 128;
    const int posq = q0 + w * 32 + r;
    const bool qvalid = posq < L;
    const int pq = qvalid ? posq : L - 1;
    bf16_t* qptr = aa.q + (size_t)(b * L + pq) * aa.ldq + hd * aa.hs;
    bf16x8 qf[NKS];
#pragma unroll
    for (int ks = 0; ks < NKS; ++ks) qf[ks] = *(const bf16x8*)(qptr + ks * 16 + 8 * hh);
    if (MODE == 1) {
#pragma unroll
      for (int j = 0; j < 8; j += 2) {
        float o1[2], o2[2];
#pragma unroll
        for (int e = 0; e < 2; ++e) {
          const int i = 8 * hh + j + e;
          const float inv = fexp2(-(float)i * 0.83048202f);
          const float ang = (float)pq * inv;
          const float n = rintf(ang * 0.15915494f);
          float rr = fmaf(-n, 6.2831855f, ang); rr = fmaf(-n, -1.7484555e-7f, rr);
          const float cs = __cosf(rr), sn = __sinf(rr);
          const float x1 = bf2f(qf[NKS - 2][j + e]), x2 = bf2f(qf[NKS - 1][j + e]);
          o1[e] = x1 * cs - x2 * sn; o2[e] = x2 * cs + x1 * sn;
        }
        const unsigned p1 = pk_bf16(o1[0], o1[1]), p2 = pk_bf16(o2[0], o2[1]);
        qf[NKS - 2][j] = (short)(p1 & 0xffff); qf[NKS - 2][j + 1] = (short)(p1 >> 16);
        qf[NKS - 1][j] = (short)(p2 & 0xffff); qf[NKS - 1][j + 1] = (short)(p2 >> 16);
      }
    }
    float Bq = 0.f;
    if (MODE == 2) {
      float qq = 0.f;
#pragma unroll
      for (int ks = 0; ks < NKS; ++ks)
#pragma unroll
        for (int j = 0; j < 8; ++j) { const float x = bf2f(qf[ks][j]); qq += x * x; }
      qq += __shfl_xor(qq, 32);
      Bq = sqrtf(qq) * sqrtf(__uint_as_float(aa.kmax[bh])) * (c2 * 1.02f);
    }

    int kt = (q0 + 127) >> 6; if (kt > (L - 1) >> 6) kt = (L - 1) >> 6;
    const int wqmax = q0 + w * 32 + 31;
    const bf16_t* vsrc = aa.vt + ((size_t)(bh * 64 + lkey)) * LP + lsub * 8;
    u32x4 rkA[KCH], rvA[2], rkB[KCH], rvB[2]; float rfA = 0.f, rfB = 0.f;
    auto gload = [&](u32x4 (&rk)[KCH], u32x4 (&rv)[2], float& rf, int ktile) {
      int kp = ktile * 64 + lkey; kp = kp < L ? kp : L - 1;
      const size_t mk = (size_t)(b * L + kp);
      const bf16_t* ks_ = aa.k + mk * D + hd * 64 + lsub * 8;
      rk[0] = *(const u32x4*)ks_; __builtin_amdgcn_sched_barrier(0);
      rk[1] = *(const u32x4*)(ks_ + 32); __builtin_amdgcn_sched_barrier(0);
      if (MODE == 1) { rk[KCH - 1] = *(const u32x4*)(aa.kr + mk * 32 + lsub * 8); __builtin_amdgcn_sched_barrier(0); }
      rv[0] = *(const u32x4*)(vsrc + ktile * 64); __builtin_amdgcn_sched_barrier(0);
      rv[1] = *(const u32x4*)(vsrc + ktile * 64 + 32); __builtin_amdgcn_sched_barrier(0);
      if (MODE == 2) { rf = aa.Fh[(size_t)bh * LP + ktile * 64 + (t & 63)]; __builtin_amdgcn_sched_barrier(0); }
    };
    auto lstore = [&](const u32x4 (&rk)[KCH], const u32x4 (&rv)[2], const float rf, int buf) {
      bf16_t* kd = Kl + buf * 64 * KST + lkey * KST + lsub * 8;
      *(u32x4*)kd = rk[0]; *(u32x4*)(kd + 32) = rk[1];
      if (MODE == 1) *(u32x4*)(kd + 64) = rk[KCH - 1];
      bf16_t* vd = Vl + buf * 64 * VST + lkey * VST + lsub * 8;
      u32x2 lo, hi;
      lo[0] = rv[0][0]; lo[1] = rv[0][1]; hi[0] = rv[0][2]; hi[1] = rv[0][3];
      *(u32x2*)vd = lo; *(u32x2*)(vd + 4) = hi;
      lo[0] = rv[1][0]; lo[1] = rv[1][1]; hi[0] = rv[1][2]; hi[1] = rv[1][3];
      *(u32x2*)(vd + 32) = lo; *(u32x2*)(vd + 36) = hi;
      if (MODE == 2 && t < 64) Fl[buf * 64 + t] = -rf * LOG2E;
    };
    gload(rkA, rvA, rfA, kt); gload(rkB, rvB, rfB, kt > 0 ? kt - 1 : 0); lstore(rkA, rvA, rfA, 0);

    f32x16 oacc[2];
#pragma unroll
    for (int i = 0; i < 16; ++i) { oacc[0][i] = 0.f; oacc[1][i] = 0.f; }
    float mrun = -1e30f, lsum = 0.f, Rrun = 0.f, nfnext = 3.0e38f;
    auto iter = [&](auto PARC) -> bool {
      constexpr int PAR = decltype(PARC)::value;
      if (MODE != 1) {
        const int dn = (MODE == 0) ? ((!qvalid) || (Rrun < -120.f)) : ((!qvalid) || (Bq + nfnext < mrun - 150.f));
        const int wd = __all(dn) ? 1 : 0;
        if (lane == 0) s_flag[PAR * 4 + w] = wd;
        __syncthreads();
        const int f0 = s_flag[PAR * 4 + 0], f1 = s_flag[PAR * 4 + 1], f2 = s_flag[PAR * 4 + 2], f3 = s_flag[PAR * 4 + 3];
        if (f0 & f1 & f2 & f3) return true;
      } else {
        __syncthreads();
      }
      constexpr int buf = PAR;
      if (MODE == 2) { const float fl = aa.Fh[(size_t)bh * LP + (kt > 0 ? kt * 64 - 1 : 0)]; __builtin_amdgcn_sched_barrier(0); nfnext = (kt > 0) ? -fl * LOG2E : 0.f; }
      { const int kpre = kt > 1 ? kt - 2 : 0; if (PAR == 0) gload(rkA, rvA, rfA, kpre); else gload(rkB, rvB, rfB, kpre); }
      if (kt * 64 <= wqmax && dry < 2) {
        const bf16_t* Kb = Kl + buf * 64 * KST; const bf16_t* Vb = Vl + buf * 64 * VST;
        f32x16 s[2];
#pragma unroll
        for (int i = 0; i < 16; ++i) { s[0][i] = 0.f; s[1][i] = 0.f; }
        if (MODE == 0) {
#pragma unroll
          for (int ks = 0; ks < NKS; ++ks) {
            const bf16x8 a0 = *(const bf16x8*)(Kb + r * KST + ks * 16 + 8 * hh);
            const bf16x8 a1 = *(const bf16x8*)(Kb + (32 + r) * KST + ks * 16 + 8 * hh);
            s[0] = MFMA32(a0, qf[ks], s[0]);
            s[1] = MFMA32(a1, qf[ks], s[1]);
          }
        } else {
          bf16x8 kf0[NKS], kf1[NKS];
#pragma unroll
          for (int ks = 0; ks < NKS; ++ks) kf0[ks] = *(const bf16x8*)(Kb + r * KST + ks * 16 + 8 * hh);
#pragma unroll
          for (int ks = 0; ks < NKS; ++ks) kf1[ks] = *(const bf16x8*)(Kb + (32 + r) * KST + ks * 16 + 8 * hh);
          __builtin_amdgcn_sched_barrier(0);
          __builtin_amdgcn_s_setprio(1);
#pragma unroll
          for (int ks = 0; ks < NKS; ++ks) s[0] = MFMA32(kf0[ks], qf[ks], s[0]);
#pragma unroll
          for (int ks = 0; ks < NKS; ++ks) s[1] = MFMA32(kf1[ks], qf[ks], s[1]);
          __builtin_amdgcn_s_setprio(0);
          __builtin_amdgcn_sched_barrier(0);
        }
        const int kbase = kt * 64 + 4 * hh;
        u32x4 vfr[2][2];
        auto ldv = [&](int j) {
#pragma unroll
          for (int st = 0; st < 2; ++st)
#pragma unroll
            for (int dt = 0; dt < 2; ++dt) {
              const bf16_t* vp = Vb + (dt * 32 + r) * VST + j * 32 + 16 * st + 4 * hh;
              const u32x2 lo = *(const u32x2*)vp, hi = *(const u32x2*)(vp + 8);
              vfr[st][dt][0] = lo[0]; vfr[st][dt][1] = lo[1]; vfr[st][dt][2] = hi[0]; vfr[st][dt][3] = hi[1];
            }
          __builtin_amdgcn_sched_barrier(0);
        };
        auto pvm = [&](int j) {
#pragma unroll
          for (int st = 0; st < 2; ++st) {
            u32x4 pp;
#pragma unroll
            for (int q = 0; q < 4; ++q) pp[q] = pk_bf16(s[j][8 * st + 2 * q], s[j][8 * st + 2 * q + 1]);
            const bf16x8 pb = __builtin_bit_cast(bf16x8, pp);
            __builtin_amdgcn_s_setprio(1);
#pragma unroll
            for (int dt = 0; dt < 2; ++dt) oacc[dt] = MFMA32(__builtin_bit_cast(bf16x8, vfr[st][dt]), pb, oacc[dt]);
            __builtin_amdgcn_s_setprio(0);
          }
        };
        auto pv = [&](int j) { ldv(j); pvm(j); };
        if (MODE == 0) {
          float Gs[8]; float lk[2][16];
#pragma unroll
          for (int j = 0; j < 2; ++j)
#pragma unroll
            for (int g = 0; g < 4; ++g) {
              float gsum = 0.f;
#pragma unroll
              for (int e = 0; e < 4; ++e) {
                const int i = 4 * g + e;
                const float z = s[j][i] * 0.125f;
                const float sp = fmaxf(z, 0.f) + 0.69314718f * flog2(1.f + fexp2(-fabsf(z) * LOG2E));
                const bool valid = (kbase + j * 32 + 8 * g + e) < posq;
                const float l = valid ? -sp : 0.f;
                lk[j][i] = l; gsum += l;
                s[j][i] = z - sp;
              }
              Gs[j * 4 + g] = gsum;
            }
          float inc[9]; float run = 0.f; inc[8] = 0.f;
#pragma unroll
          for (int q = 7; q >= 0; --q) { run += Gs[q]; inc[q] = run; }
          float recv[8];
#pragma unroll
          for (int q = 0; q < 8; ++q) recv[q] = __shfl_xor(inc[q + 1] + (hh ? Gs[q] : 0.f), 32);
          const float ptot = __shfl_xor(run, 32);
#pragma unroll
          for (int j = 0; j < 2; ++j)
#pragma unroll
            for (int g = 0; g < 4; ++g) {
              const int q = j * 4 + g;
              float later = Rrun + inc[q + 1] + recv[q];
#pragma unroll
              for (int e = 3; e >= 0; --e) {
                const int i = 4 * g + e;
                const bool valid = (kbase + j * 32 + 8 * g + e) < posq;
                const float a = valid ? fexp2((s[j][i] + later) * LOG2E) : 0.f;
                later += lk[j][i];
                s[j][i] = a;
              }
            }
          Rrun += run + ptot;
        } else {
          const bool diag = kt * 64 + 63 > q0 + w * 32;
          const int dq = posq - kbase;
#pragma unroll
          for (int j = 0; j < 2; ++j) {
            ldv(j);
            if (MODE == 2) {
#pragma unroll
              for (int g = 0; g < 4; ++g) {
                const f32x4 nf = *(const f32x4*)(Fl + buf * 64 + j * 32 + 8 * g + 4 * hh);
#pragma unroll
                for (int e = 0; e < 4; ++e) s[j][4 * g + e] = fmaf(s[j][4 * g + e], c2, nf[e]);
              }
            }
            if (diag) {
              asm volatile("" ::: "memory");
#pragma unroll
              for (int i = 0; i < 16; ++i) s[j][i] = (j * 32 + 8 * (i >> 2) + (i & 3)) <= dq ? s[j][i] : -INFINITY;
            }
            float mt = fmaxf(s[j][0], s[j][1]);
#pragma unroll
            for (int i = 2; i < 16; ++i) mt = fmaxf(mt, s[j][i]);
            mt = fmaxf(mt, __shfl_xor(mt, 32));
            if (MODE == 1) mt *= c2;
            const float cand = fmaxf(mrun, mt);
            if (__any(cand > mrun + 8.f)) {
              const float alpha = fexp2(mrun - cand);
              mrun = cand; lsum *= alpha;
#pragma unroll
              for (int i = 0; i < 16; ++i) { oacc[0][i] *= alpha; oacc[1][i] *= alpha; }
            }
            const float nm = -mrun;
#pragma unroll
            for (int i = 0; i < 16; ++i) {
              const float p = (MODE == 1) ? fexp2(fmaf(s[j][i], c2, nm)) : fexp2(s[j][i] + nm);
              lsum += p; s[j][i] = p;
            }
            pvm(j);
          }
        }
        if (MODE == 0) { pv(0); pv(1); }
      }
      { if (PAR == 0) lstore(rkB, rvB, rfB, 1); else lstore(rkA, rvA, rfA, 0); }
      --kt;
      return kt < 0;
    };
    for (;;) {
      if (iter(std::integral_constant<int, 0>{})) break;
      if (iter(std::integral_constant<int, 1>{})) break;
    }
    float inv = 1.f;
    if (MODE != 0) { const float lt = lsum + __shfl_xor(lsum, 32); inv = 1.f / lt; }
    if (qvalid && !dry) {
#pragma unroll
      for (int dt = 0; dt < 2; ++dt)
#pragma unroll
        for (int g = 0; g < 4; ++g) {
          u32x2 o;
          o[0] = pk_bf16(oacc[dt][4 * g + 0] * inv, oacc[dt][4 * g + 1] * inv);
          o[1] = pk_bf16(oacc[dt][4 * g + 2] * inv, oacc[dt][4 * g + 3] * inv);
          *(u32x2*)(qptr + dt * 32 + 8 * g + 4 * hh) = o;
        }
    }
  }
}

DI void prep_tile(const PrepJob& j, int lt, float* tl  ) {
  const int t = otid();
  const int kt = lt / j.ntn, nt = lt - kt * j.ntn;
  const int k0 = kt * 64, n0 = nt * 64;
  __syncthreads();
  {
    const int n4 = n0 + (t & 15) * 4, kq = t >> 4;
    const bool nv = n4 < j.Njob;
    const int ns = nv ? (n4 / j.sblk) * j.sstride + j.soff + n4 % j.sblk : 0;
    f32x4 cs = {1.f, 1.f, 1.f, 1.f};
    if (nv && j.colscale) cs = *(const f32x4*)(j.colscale + ns);
    f32x4 v[4]; float gk[4];
#pragma unroll
    for (int i = 0; i < 4; ++i) {
      const int k = kq + 16 * i;
      v[i] = nv ? *(const f32x4*)(j.src + (size_t)(k0 + k) * j.ld_src + ns) : (f32x4){0.f, 0.f, 0.f, 0.f};
      gk[i] = j.gain ? j.gain[k0 + k] : 1.f;
    }
#pragma unroll
    for (int i = 0; i < 4; ++i) {
      const int k = kq + 16 * i;
#pragma unroll
      for (int e = 0; e < 4; ++e) tl[k * 65 + (t & 15) * 4 + e] = v[i][e] * cs[e] * gk[i];
    }
  }
  __syncthreads();
#pragma unroll
  for (int c = t; c < 512; c += 256) {
    const int nl = c >> 3, kc = c & 7;
    const int n = n0 + nl;
    if (n < j.Npad) {
      const int drow = (n / j.dblk) * j.dstride + j.doff + n % j.dblk;
      u32x4 o;
#pragma unroll
      for (int q = 0; q < 4; ++q) o[q] = pk_bf16(tl[(kc * 8 + 2 * q) * 65 + nl], tl[(kc * 8 + 2 * q + 1) * 65 + nl]);
      *(u32x4*)(j.dst + (size_t)drow * j.ld_dst + k0 + kc * 8) = o;
    }
  }
}

constexpr int PT = 24;
DI void pool_tile(const Params& p, int tile, float* s_rstd  ) {
  const int t = otid(), lane = t & 63, w = t >> 6;
  const int b = tile / (L / PT), p0 = (tile - b * (L / PT)) * PT;
  const float* x = p.in[0]; const float* meta = p.in[1]; const float* gmix = p.in[2];
  auto rowptr = [&](int pos) -> const float* {
    return pos < NMETA ? meta + (size_t)pos * D : x + ((size_t)b * SEQ + (pos - NMETA)) * D;
  };
  __syncthreads();
  for (int j = w; j < PT + 15; j += 4) {
    const int pj = p0 - 15 + j;
    if (pj >= 0) {
      const float* rp = rowptr(pj);
      float ss = 0.f;
#pragma unroll
      for (int i = 0; i < 4; ++i) { const f32x4 v = *(const f32x4*)(rp + (lane + 64 * i) * 4); ss += v[0] * v[0] + v[1] * v[1] + v[2] * v[2] + v[3] * v[3]; }
#pragma unroll
      for (int o = 32; o > 0; o >>= 1) ss += __shfl_xor(ss, o);
      if (lane == 0) s_rstd[j] = rsqrtf(ss * (1.f / D) + EPS);
    }
  }
  __syncthreads();
  const int c = t * 4, win = 2 << (t >> 6);
  const f32x4 gn = *(const f32x4*)(gmix + c);
  auto aval = [&](int pos) -> f32x4 {
    const f32x4 v = *(const f32x4*)(rowptr(pos) + c);
    const float rs = s_rstd[pos - (p0 - 15)];
    f32x4 o; o[0] = v[0] * rs * gn[0]; o[1] = v[1] * rs * gn[1]; o[2] = v[2] * rs * gn[2]; o[3] = v[3] * rs * gn[3];
    return o;
  };
  f32x4 s = {0.f, 0.f, 0.f, 0.f};
  for (int j = p0 - win + 1; j < p0; ++j) if (j >= 0) { const f32x4 a = aval(j); s += a; }
#pragma unroll 1
  for (int pc = p0; pc < p0 + PT; pc += 8) {
    f32x4 raw[8], oldv[8];
#pragma unroll
    for (int i = 0; i < 8; ++i) {
      raw[i] = *(const f32x4*)(rowptr(pc + i) + c);
      const int po = pc + i - win + 1;
      oldv[i] = *(const f32x4*)(rowptr(po >= 0 ? po : 0) + c);
    }
#pragma unroll
    for (int i = 0; i < 8; ++i) {
      const int pos = pc + i;
      const size_t m = (size_t)b * L + pos;
      { u32x2 hr; hr[0] = pk_bf16(raw[i][0], raw[i][1]); hr[1] = pk_bf16(raw[i][2], raw[i][3]); *(u32x2*)(p.hb + m * D + c) = hr; }
      const float rs = s_rstd[pos - (p0 - 15)];
      f32x4 a; a[0] = raw[i][0] * rs * gn[0]; a[1] = raw[i][1] * rs * gn[1]; a[2] = raw[i][2] * rs * gn[2]; a[3] = raw[i][3] * rs * gn[3];
      s += a;
      const int cnt = (pos + 1) < win ? (pos + 1) : win;
      const float ic = 1.f / (float)cnt;
      u32x2 o; o[0] = pk_bf16(s[0] * ic - a[0], s[1] * ic - a[1]); o[1] = pk_bf16(s[2] * ic - a[2], s[3] * ic - a[3]);
      *(u32x2*)(p.R + m * D + c) = o;
      const int po = pos - win + 1;
      if (po >= 0) {
        const float ro = s_rstd[po - (p0 - 15)];
        s[0] -= oldv[i][0] * ro * gn[0]; s[1] -= oldv[i][1] * ro * gn[1]; s[2] -= oldv[i][2] * ro * gn[2]; s[3] -= oldv[i][3] * ro * gn[3];
      }
    }
  }
}

DI void zero_vt_pad(bf16_t* vt) {
  const int total = NB * NH * 64 * 6;
  for (int i = blockIdx.x * NTHREADS + threadIdx.x; i < total; i += gridDim.x * NTHREADS) {
    const int row = i / 6, c = i - row * 6;
    u32x4 z = {0u, 0u, 0u, 0u};
    *(u32x4*)(vt + (size_t)row * LP + L + c * 8) = z;
  }
}

DI void kr_rope_phase(const Params& p) {
  const int total = M * 16;
  for (int i = blockIdx.x * NTHREADS + threadIdx.x; i < total; i += gridDim.x * NTHREADS) {
    const int m = i >> 4, e = i & 15;
    const int pos = m % L;
    const float x1 = bf2f((short)p.down[(size_t)m * 768 + 640 + e]), x2 = bf2f((short)p.down[(size_t)m * 768 + 656 + e]);
    const float inv = fexp2(-(float)e * 0.83048202f);
    const float ang = (float)pos * inv;
    const float n = rintf(ang * 0.15915494f);
    float rr = fmaf(-n, 6.2831855f, ang); rr = fmaf(-n, -1.7484555e-7f, rr);
    const float cs = __cosf(rr), sn = __sinf(rr);
    const unsigned o1 = pk_bf16(x1 * cs - x2 * sn, 0.f), o2 = pk_bf16(x2 * cs + x1 * sn, 0.f);
    p.kr[(size_t)m * 32 + e] = (bf16_t)(o1 & 0xffff);
    p.kr[(size_t)m * 32 + 16 + e] = (bf16_t)(o2 & 0xffff);
  }
}

DI void fox_scan_phase(const Params& p, float* sm  ) {
  const int t = otid();
  constexpr int SEG = 36, NSEG = L / SEG;
  for (int bh = blockIdx.x; bh < NB * NH; bh += gridDim.x) {
    const int b = bh >> 4, hd = bh & 15;
    __syncthreads();
    float v[SEG]; float tot = 0.f;
    if (t < NSEG) {
      const float* src = p.flog + ((size_t)b * L + t * SEG) * 16 + hd;
#pragma unroll
      for (int i = 0; i < SEG; ++i) { tot += src[(size_t)i * 16]; v[i] = tot; }
      sm[t] = tot;
    }
    __syncthreads();
    if (t == 0) { float run = 0.f; for (int i = 0; i < NSEG; ++i) { const float x = sm[i]; sm[i] = run; run += x; } }
    __syncthreads();
    if (t < NSEG) {
      const float base = sm[t];
      float* dst = p.Fh + (size_t)bh * LP + t * SEG;
#pragma unroll
      for (int i = 0; i < SEG; ++i) dst[i] = base + v[i];
    }
  }
}

DI void final_phase(const Params& p) {
  const u64* ssq = p.ssq + 7 * (size_t)M; const float* g = p.in[20];
  const int total = NB * SEQ * (D / 4), stride = gridDim.x * NTHREADS;
  for (int i0 = blockIdx.x * NTHREADS + threadIdx.x; i0 < total; i0 += 4 * stride) {
    u32x2 hr[4]; u64 sq[4];
#pragma unroll
    for (int u = 0; u < 4; ++u) {
      const int i = (i0 + u * stride) < total ? (i0 + u * stride) : i0;
      const int row = i >> 8, c = (i & 255) * 4;
      const int b = row / SEQ, sx = row - b * SEQ;
      const size_t m = (size_t)b * L + NMETA + sx;
      hr[u] = *(const u32x2*)(p.hb + m * D + c); sq[u] = ssq[m];
    }
#pragma unroll
    for (int u = 0; u < 4; ++u) {
      const int i = i0 + u * stride;
      if (i < total) {
        const int row = i >> 8, c = (i & 255) * 4;
        const f32x4 gv = *(const f32x4*)(g + c);
        const float rs = rsqrtf(ssq_f(sq[u]) * (1.f / D) + EPS);
        f32x4 o;
        o[0] = __uint_as_float(hr[u][0] << 16) * rs * gv[0]; o[1] = __uint_as_float(hr[u][0] & 0xffff0000u) * rs * gv[1];
        o[2] = __uint_as_float(hr[u][1] << 16) * rs * gv[2]; o[3] = __uint_as_float(hr[u][1] & 0xffff0000u) * rs * gv[3];
        *(f32x4*)(p.out + (size_t)row * D + c) = o;
      }
    }
  }
}

constexpr size_t R_K_SB = (size_t)M * 1024, R_VT_SB = (size_t)M * 2048;
constexpr size_t R_K_MLA = (size_t)M * 1536, R_VT_MLA = (size_t)M * 2560;

DI GemmDesc make_desc(const Params& p, int gi) {
  GemmDesc d;
  d.A = p.hb; d.Bt = nullptr; d.lda = D; d.a_cs = 64; d.ldb = D; d.K = D; d.N = D; d.epi = EPI_RESID; d.a_grp = 0;
  d.ssq_in = nullptr; d.inv_dim = 1.f / D; d.h = p.h; d.hb = p.hb; d.ssq_out = nullptr; d.c_off = 0;
  d.d0 = nullptr; d.ld0 = D; d.n0end = 0; d.d1 = nullptr; d.ld1 = D; d.n1end = 0; d.vt = nullptr; d.nvend = 0;
  d.ssq_a = nullptr; d.ssq_a_end = 0; d.ssq_b = nullptr; d.ssq_b_end = 0; d.flog = nullptr; d.bfv = nullptr; d.act = nullptr; d.kmax = nullptr;
  u64* ssq = p.ssq;
  if (gi < 4) {
    d.A = p.R; d.a_grp = 256; d.Bt = p.w_pool; d.ldb = 256; d.K = 256; d.N = 1024; d.ssq_out = ssq;
  } else if (gi < 12) {
    const int l = (gi - 4) >> 1;
    if (((gi - 4) & 1) == 0) {
      d.Bt = p.w_gu + (size_t)l * 5632 * 1024; d.N = 5632; d.epi = EPI_SWIGLU; d.ssq_in = ssq + (size_t)(2 * l) * M; d.act = p.R;
    } else {
      d.A = p.R; d.lda = DFF; d.K = DFF; d.Bt = p.w_dn + (size_t)l * 1024 * DFF; d.ldb = DFF; d.ssq_out = ssq + (size_t)(2 * l + 1) * M;
    }
  } else if (gi == 12 || gi == 18) {
    const bool fox = gi == 18;
    d.Bt = fox ? p.w_fqkvf : p.w_sbqkv; d.N = fox ? 3200 : 3072; d.epi = EPI_STORE; d.ssq_in = ssq + (size_t)(fox ? 5 : 1) * M;
    d.d0 = p.R; d.n0end = 1024; d.d1 = p.R + R_K_SB; d.n1end = 2048; d.vt = p.R + R_VT_SB; d.nvend = 3072;
    d.flog = p.flog; d.bfv = p.in[15]; d.kmax = fox ? (p.counters + 16) : nullptr;
  } else if (gi == 13 || gi == 19) {
    d.A = p.R; d.Bt = gi == 13 ? p.w_sbo : p.w_fo; d.ssq_out = ssq + (size_t)(gi == 13 ? 2 : 6) * M;
  } else if (gi == 14) {
    d.Bt = p.w_mdown; d.N = 768; d.epi = EPI_STORE; d.ssq_in = ssq + (size_t)3 * M;
    d.d0 = p.down; d.ld0 = 768; d.n0end = 768; d.n1end = 768; d.nvend = 768;
    d.ssq_a = ssq + (size_t)8 * M; d.ssq_a_end = 384; d.ssq_b = ssq + (size_t)9 * M; d.ssq_b_end = 640;
  } else if (gi == 15) {
    d.A = p.down; d.lda = 768; d.K = 384; d.Bt = p.w_muq; d.ldb = 384; d.N = 1536; d.epi = EPI_STORE;
    d.ssq_in = ssq + (size_t)8 * M; d.inv_dim = 1.f / 384;
    d.d0 = p.R; d.ld0 = 1536; d.n0end = 1536; d.n1end = 1536; d.nvend = 1536;
  } else if (gi == 16) {
    d.A = p.down + 384; d.lda = 768; d.K = 256; d.Bt = p.w_mukv; d.ldb = 256; d.N = 2048; d.epi = EPI_STORE;
    d.ssq_in = ssq + (size_t)9 * M; d.inv_dim = 1.f / 256;
    d.n0end = 0; d.d1 = p.R + R_K_MLA; d.n1end = 1024; d.vt = p.R + R_VT_MLA; d.nvend = 2048;
  } else {
    d.A = p.R; d.lda = 1536; d.a_cs = 96; d.Bt = p.w_mo; d.ssq_out = ssq + (size_t)4 * M;
  }
  return d;
}

template <int GI> DI void run_gemm(const Params& p, bf16_t* smem) { const GemmDesc d = make_desc(p, GI); if (PROBE_ON && p.probe & 1) gemm_phase(d, smem, p.dryv); gemm_phase(d, smem); }
DI void run_ffn(const Params& p, int l, bool down, bf16_t* smem) { const GemmDesc d = make_desc(p, 4 + 2 * l + (down ? 1 : 0)); if (PROBE_ON && p.probe & 2) gemm_phase(d, smem, p.dryv); if ((PROBE_ON && p.probe & 64) && !down) gemm_phase(d, smem, 0); if ((PROBE_ON && p.probe & 512) && !down) gemm_phase(d, smem, p.dryv); gemm_phase(d, smem); }

#define XB_TMO      128
#define XB_XCNT(j)  (256  + 64 * (j))
#define XB_XSUB(j)  (1280 + 64 * (j))
#define XB_XGEN(j)  (2304 + 64 * (j))
#define XB_TOP      3328
#define XB_TOPGEN   3392
#define XCD_BAR_WORDS 3456
#define XB_SPIN_CAP (1u << 18)
#define LAS __attribute__((address_space(3)))
DI unsigned xb_ld(unsigned* p)              { return __hip_atomic_load(p, __ATOMIC_RELAXED, __HIP_MEMORY_SCOPE_AGENT); }
DI unsigned xb_add(unsigned* p, unsigned v) { return __hip_atomic_fetch_add(p, v, __ATOMIC_RELAXED, __HIP_MEMORY_SCOPE_AGENT); }
#define XB_SPIN(cond, bar) do { unsigned _sp = 0; while (cond) { __builtin_amdgcn_s_sleep(1); \
    if ((++_sp & 255u) == 0u) { if (xb_ld(&(bar)[XB_TMO])) break; if (_sp > XB_SPIN_CAP) { atomicAdd(&(bar)[XB_TMO], 1u); break; } } } } while (0)
struct XcdBarrier { unsigned* bar; unsigned x; volatile LAS unsigned* st; };
DI XcdBarrier xcd_barrier_post(unsigned* bar, volatile LAS unsigned* st) {
  XcdBarrier b; b.bar = bar; b.x = xb_xcc_id(); b.st = st;
  if (threadIdx.x == 0) (void)xb_add(&bar[XB_XCNT(b.x)], 1u);
  return b;
}
DI void xcd_barrier_complete(unsigned* bar, unsigned x, unsigned& nloc, unsigned& nx) {
  const unsigned G = gridDim.x * gridDim.y * gridDim.z;
  unsigned sum, cnt, mine, sp = 0u;
  for (;;) {
    sum = 0u; cnt = 0u; mine = 0u;
#pragma unroll
    for (unsigned j = 0; j < 16; ++j) { const unsigned c = xb_ld(&bar[XB_XCNT(j)]); sum += c; cnt += (c > 0u) ? 1u : 0u; mine = (j == x) ? c : mine; }
    if (sum == G) break;
    __builtin_amdgcn_s_sleep(1);
    if ((++sp & 255u) == 0u) { if (xb_ld(&bar[XB_TMO])) break; if (sp > XB_SPIN_CAP) { atomicAdd(&bar[XB_TMO], 1u); break; } }
  }
  nloc = mine > 0u ? mine : 1u; nx = cnt > 0u ? cnt : 1u;
}
DI void xcd_barrier(const XcdBarrier& b) {
  asm volatile("s_waitcnt vmcnt(0)" ::: "memory");
  __syncthreads();
  if (threadIdx.x == 0) {
    unsigned* bar = b.bar;
    __builtin_amdgcn_s_waitcnt(0);
    unsigned nloc = b.st[0], nx = b.st[1];
    if (nloc == 0u) { xcd_barrier_complete(bar, b.x, nloc, nx); b.st[0] = nloc; b.st[1] = nx; }
    const unsigned old = xb_add(&bar[XB_XSUB(b.x)], 1u);
    const unsigned gen = old / nloc;
    if (old + 1u == (gen + 1u) * nloc) {
      __builtin_amdgcn_fence(__ATOMIC_RELEASE, "agent");
      asm volatile("s_waitcnt vmcnt(0)" ::: "memory");
      const unsigned og = xb_add(&bar[XB_TOP], 1u);
      const unsigned tg = og / nx;
      if (og + 1u == (tg + 1u) * nx) xb_add(&bar[XB_TOPGEN], 1u);
      else XB_SPIN(xb_ld(&bar[XB_TOPGEN]) == tg, bar);
      __builtin_amdgcn_fence(__ATOMIC_ACQUIRE, "agent");
      xb_add(&bar[XB_XGEN(b.x)], 1u);
      asm volatile("s_waitcnt vmcnt(0)" ::: "memory");
    } else {
      XB_SPIN(xb_ld(&bar[XB_XGEN(b.x)]) == gen, bar);
      __builtin_amdgcn_fence(__ATOMIC_ACQUIRE, "agent");
      asm volatile("s_waitcnt vmcnt(0)" ::: "memory");
    }
  }
  __syncthreads();
}
#define PHASE(body) { if (cur >= ph_begin && cur < ph_end) { body; if (cur + 1 < ph_end) { xcd_barrier(xb); if (PROBE_ON && p.probe & 256) { xcd_barrier(xb); xcd_barrier(xb); xcd_barrier(xb); xcd_barrier(xb); } } } ++cur; }

__global__ void __launch_bounds__(NTHREADS, 2) fwd_kernel(Params p, int ph_begin, int ph_end) {
  __shared__ __attribute__((aligned(16))) unsigned char smem_raw[SMEM_BYTES];
  bf16_t* smem = (bf16_t*)smem_raw;
  cg::grid_group grid = cg::this_grid();
  if (ph_begin < 0) grid.sync();
  __shared__ uint4 xb_words;
  if (threadIdx.x == 0) xb_words = make_uint4(0u, 0u, 0u, 0u);
  __syncthreads();
  XcdBarrier xb; xb.bar = p.bar; xb.x = 0; xb.st = (volatile LAS unsigned*)&xb_words;
  if (ph_end - ph_begin > 1) xb = xcd_barrier_post(p.bar, (volatile LAS unsigned*)&xb_words);
  int cur = 0;
  PHASE({
   for (int rep = (PROBE_ON && p.probe & 32) ? 0 : 1; rep < 2; ++rep) {
    for (int i = blockIdx.x * NTHREADS + threadIdx.x; i < 10 * M + 128; i += gridDim.x * NTHREADS) {
      if (i < 10 * M) p.ssq[i] = 0ull; else p.counters[i - 10 * M] = 0u;
    }
    for (int tile = blockIdx.x; tile < NB * (L / PT); tile += gridDim.x) pool_tile(p, tile, (float*)smem);
    for (int tile = blockIdx.x; tile < p.prep_tiles; tile += gridDim.x) {
      int ji = 0;
      _Pragma("unroll 1") for (int q = 1; q < NJOBS; ++q) if (tile >= p.jobs[q].tile_start) ji = q;
      prep_tile(p.jobs[ji], tile - p.jobs[ji].tile_start, (float*)smem);
    }
   }
  })
#pragma unroll 1
  for (int l = 0; l < 4; ++l) {
    if (l == 0) {
      PHASE({ run_gemm<0>(p, smem); })
    } else if (l == 1) {
      PHASE({ zero_vt_pad(p.R + R_VT_SB); run_gemm<12>(p, smem); })
      PHASE({
        AttnArgs aa; aa.q = p.R; aa.ldq = 1024; aa.hs = 64; aa.k = p.R + R_K_SB; aa.kr = nullptr; aa.vt = p.R + R_VT_SB; aa.Fh = nullptr; aa.ctr = p.counters + 80; aa.kmax = nullptr;
        if (PROBE_ON && p.probe & 4) { AttnArgs ab = aa; ab.ctr = p.counters + 104; attn_phase<0>(ab, smem, p.dryv); }
        attn_phase<0>(aa, smem);
      })
      PHASE({ run_gemm<13>(p, smem); })
    } else if (l == 2) {
      PHASE({ run_gemm<14>(p, smem); })
      PHASE({ zero_vt_pad(p.R + R_VT_MLA); kr_rope_phase(p); run_gemm<15>(p, smem); run_gemm<16>(p, smem); })
      PHASE({
        AttnArgs aa; aa.q = p.R; aa.ldq = 1536; aa.hs = 96; aa.k = p.R + R_K_MLA; aa.kr = p.kr; aa.vt = p.R + R_VT_MLA; aa.Fh = nullptr; aa.ctr = p.counters + 88; aa.kmax = nullptr;
        if (PROBE_ON && p.probe & 8) { AttnArgs ab = aa; ab.ctr = p.counters + 112; attn_phase<1>(ab, smem, p.dryv); }
        attn_phase<1>(aa, smem);
      })
      PHASE({ run_gemm<17>(p, smem); })
    } else {
      PHASE({ zero_vt_pad(p.R + R_VT_SB); run_gemm<18>(p, smem); })
      PHASE({ if (PROBE_ON && p.probe & 128) fox_scan_phase(p, (float*)smem); fox_scan_phase(p, (float*)smem); })
      PHASE({
        AttnArgs aa; aa.q = p.R; aa.ldq = 1024; aa.hs = 64; aa.k = p.R + R_K_SB; aa.kr = nullptr; aa.vt = p.R + R_VT_SB; aa.Fh = p.Fh; aa.ctr = p.counters + 96; aa.kmax = p.counters + 16;
        if (PROBE_ON && p.probe & 16) { AttnArgs ab = aa; ab.ctr = p.counters + 120; attn_phase<2>(ab, smem, p.dryv); }
        attn_phase<2>(aa, smem);
      })
      PHASE({ run_gemm<19>(p, smem); })
    }
    PHASE({ run_ffn(p, l, false, smem); })
    PHASE({ run_ffn(p, l, true, smem); })
  }
  PHASE({ if (PROBE_ON && p.probe & 128) final_phase(p); final_phase(p); })
}

static size_t align_up(size_t x) { return (x + 255) & ~(size_t)255; }

extern "C" void kernel_launch(void* const* d_in, const int* in_sizes, int n_in, void* d_out, int out_size, void* d_ws, size_t ws_size, hipStream_t stream) {
  (void)in_sizes; (void)n_in; (void)out_size; (void)ws_size;
  Params p;
  memset(&p, 0, sizeof(p));
  for (int i = 0; i < 21; ++i) p.in[i] = (const float*)d_in[i];
  p.out = (float*)d_out;
  unsigned char* ws = (unsigned char*)d_ws; size_t off = 0;
  auto take = [&](size_t bytes) { unsigned char* r = ws + off; off = align_up(off + bytes); return r; };
  p.w_pool = (bf16_t*)take((size_t)4 * 256 * 256 * 2);
  p.w_sbqkv = (bf16_t*)take((size_t)3072 * 1024 * 2);
  p.w_sbo = (bf16_t*)take((size_t)1024 * 1024 * 2);
  p.w_mdown = (bf16_t*)take((size_t)768 * 1024 * 2);
  p.w_muq = (bf16_t*)take((size_t)1536 * 384 * 2);
  p.w_mukv = (bf16_t*)take((size_t)2048 * 256 * 2);
  p.w_mo = (bf16_t*)take((size_t)1024 * 1024 * 2);
  p.w_fqkvf = (bf16_t*)take((size_t)3200 * 1024 * 2);
  p.w_fo = (bf16_t*)take((size_t)1024 * 1024 * 2);
  p.w_gu = (bf16_t*)take((size_t)4 * 5632 * 1024 * 2);
  p.w_dn = (bf16_t*)take((size_t)4 * 1024 * DFF * 2);
  p.h = nullptr;
  p.hb = (bf16_t*)take((size_t)M * D * 2);
  p.ssq = (u64*)take((size_t)10 * M * 8 + 512);
  p.counters = (unsigned*)(p.ssq + (size_t)10 * M);
  p.flog = (float*)take((size_t)M * 16 * 4);
  p.Fh = (float*)take((size_t)NB * NH * LP * 4);
  p.kr = (bf16_t*)take((size_t)M * 32 * 2);
  p.bar = (unsigned*)take(XCD_BAR_WORDS * 4);
  p.R = (bf16_t*)take((size_t)M * 2560 * 2 + (size_t)NB * NH * 64 * LP * 2);
  p.down = (bf16_t*)d_out;

  int nj = 0, tiles = 0;
  auto add = [&](const float* src, bf16_t* dst, const float* gain, const float* cs, int K, int Njob, int Npad, int ld_src, int ld_dst,
                 int sblk, int sstride, int soff, int dblk, int dstride, int doff) {
    PrepJob& j = p.jobs[nj++];
    j.src = src; j.dst = dst; j.gain = gain; j.colscale = cs; j.K = K; j.Njob = Njob; j.Npad = Npad; j.ld_src = ld_src; j.ld_dst = ld_dst;
    j.sblk = sblk; j.sstride = sstride; j.soff = soff; j.dblk = dblk; j.dstride = dstride; j.doff = doff;
    j.tile_start = tiles; j.ntn = (Npad + 63) / 64; tiles += (K / 64) * j.ntn;
  };
  const int BIG = 1 << 30;
  const float* nmix = p.in[2]; const float* nffn = p.in[3];
  for (int g = 0; g < 4; ++g)
    add(p.in[4] + (size_t)g * 65536, p.w_pool + (size_t)g * 65536, nullptr, p.in[5] + g * 256, 256, 256, 256, 256, 256, BIG, 0, 0, BIG, 0, 0);
  add(p.in[6], p.w_sbqkv, nmix + 1 * D, nullptr, 1024, 3072, 3072, 3072, 1024, BIG, 0, 0, BIG, 0, 0);
  add(p.in[7], p.w_sbo, nullptr, nullptr, 1024, 1024, 1024, 1024, 1024, BIG, 0, 0, BIG, 0, 0);
  add(p.in[8], p.w_mdown, nmix + 2 * D, nullptr, 1024, 672, 768, 672, 1024, BIG, 0, 0, BIG, 0, 0);
  add(p.in[11], p.w_muq, p.in[9], nullptr, 384, 1536, 1536, 1536, 384, BIG, 0, 0, BIG, 0, 0);
  add(p.in[12], p.w_mukv, p.in[10], nullptr, 256, 1024, 1024, 2048, 256, 64, 128, 0, BIG, 0, 0);
  add(p.in[12], p.w_mukv, p.in[10], nullptr, 256, 1024, 1024, 2048, 256, 64, 128, 64, BIG, 0, 1024);
  add(p.in[13], p.w_mo, nullptr, nullptr, 1024, 1024, 1024, 1024, 1024, BIG, 0, 0, BIG, 0, 0);
  add(p.in[14], p.w_fqkvf, nmix + 3 * D, nullptr, 1024, 3088, 3200, 3088, 1024, BIG, 0, 0, BIG, 0, 0);
  add(p.in[16], p.w_fo, nullptr, nullptr, 1024, 1024, 1024, 1024, 1024, BIG, 0, 0, BIG, 0, 0);
  for (int l = 0; l < 4; ++l) {
    add(p.in[17] + (size_t)l * 1024 * DFF, p.w_gu + (size_t)l * 5632 * 1024, nffn + l * D, nullptr, 1024, DFF, DFF, DFF, 1024, BIG, 0, 0, 32, 64, 0);
    add(p.in[18] + (size_t)l * 1024 * DFF, p.w_gu + (size_t)l * 5632 * 1024, nffn + l * D, nullptr, 1024, DFF, DFF, DFF, 1024, BIG, 0, 0, 32, 64, 32);
    add(p.in[19] + (size_t)l * DFF * 1024, p.w_dn + (size_t)l * 1024 * DFF, nullptr, nullptr, DFF, 1024, 1024, 1024, DFF, BIG, 0, 0, BIG, 0, 0);
  }
  p.prep_tiles = tiles;
#ifndef PROBE_MASK
#define PROBE_MASK 0
#endif
#ifndef DRYV
#define DRYV 1
#endif
  p.probe = PROBE_MASK; p.dryv = DRYV;

  static int grid_blocks = 0;
  if (!grid_blocks) {
    int dev = 0, cus = 0, per_cu = 0;
    (void)hipGetDevice(&dev);
    (void)hipDeviceGetAttribute(&cus, hipDeviceAttributeMultiprocessorCount, dev);
    (void)hipOccupancyMaxActiveBlocksPerMultiprocessor(&per_cu, fwd_kernel, NTHREADS, 0);
    if (per_cu > 2) per_cu = 2;
    if (per_cu < 1) per_cu = 1;
    grid_blocks = cus * per_cu;
  }
#ifndef MULTI_LAUNCH
#define MULTI_LAUNCH 0
#endif
#if MULTI_LAUNCH
  for (int ph = 0; ph < NPHASE; ++ph) {
    hipLaunchKernelGGL(fwd_kernel, dim3(grid_blocks), dim3(NTHREADS), 0, stream, p, ph, ph + 1);
  }
#else
  (void)hipMemsetAsync(p.bar, 0, XCD_BAR_WORDS * 4, stream);
  int b0 = 0, b1 = NPHASE;
  void* args[] = {&p, &b0, &b1};
  hipError_t e = hipLaunchCooperativeKernel((void*)fwd_kernel, dim3(grid_blocks), dim3(NTHREADS), args, 0, stream);
  if (e != hipSuccess) fprintf(stderr, "cooperative launch failed: %s (grid %d)\n", hipGetErrorString(e), grid_blocks);
#endif
}
```

```cpp
#include <hip/hip_runtime.h>
#include <hip/hip_cooperative_groups.h>
#include <stdint.h>
#include <cstdio>
#include <cstring>
#include <type_traits>
namespace cg = cooperative_groups;

typedef unsigned short bf16_t;
typedef short bf16x8 __attribute__((ext_vector_type(8)));
typedef float f32x16 __attribute__((ext_vector_type(16)));
typedef float f32x4 __attribute__((ext_vector_type(4)));
typedef float f32x2 __attribute__((ext_vector_type(2)));
typedef unsigned u32x4 __attribute__((ext_vector_type(4)));
typedef unsigned u32x2 __attribute__((ext_vector_type(2)));
typedef __bf16 bf2_t __attribute__((ext_vector_type(2)));
typedef unsigned long long u64;

#define DI __device__ __forceinline__
#define MFMA32(a, b, c) __builtin_amdgcn_mfma_f32_32x32x16_bf16((a), (b), (c), 0, 0, 0)

constexpr int NB = 4, SEQ = 8192, NMETA = 16, L = SEQ + NMETA  , M = NB * L  ;
constexpr int D = 1024, DFF = 2816, NH = 16;
constexpr int LP = 8256;
constexpr float EPS = 1e-6f;
constexpr int NTHREADS = 256;
constexpr int NPHASE = 22;
#ifndef PROBE_ON
#define PROBE_ON 0
#endif

struct PrepJob {
  const float* src; bf16_t* dst; const float* gain; const float* colscale;
  int K, Njob, Npad, ld_src, ld_dst;
  int sblk, sstride, soff, dblk, dstride, doff;
  int tile_start, ntn;
};
constexpr int NJOBS = 25;

struct Params {
  const float* in[21];
  float* out;
  bf16_t *w_pool, *w_sbqkv, *w_sbo, *w_mdown, *w_muq, *w_mukv, *w_mo, *w_fqkvf, *w_fo, *w_gu, *w_dn;
  float* h; bf16_t* hb; u64* ssq; float* flog; float* Fh; bf16_t* kr; bf16_t* down; bf16_t* R;
  unsigned* counters; unsigned* bar;
  int prep_tiles; int probe; int dryv; int pad1;
  PrepJob jobs[NJOBS];
};

enum { EPI_RESID = 0, EPI_STORE = 1, EPI_SWIGLU = 2 };

struct GemmDesc {
  const bf16_t* A; const bf16_t* Bt;
  int lda, a_cs, ldb, K, N, epi, a_grp;
  const u64* ssq_in; float inv_dim;
  float* h; bf16_t* hb; u64* ssq_out; int c_off;
  bf16_t* d0; int ld0, n0end; bf16_t* d1; int ld1, n1end; bf16_t* vt; int nvend;
  u64* ssq_a; int ssq_a_end; u64* ssq_b; int ssq_b_end;
  float* flog; const float* bfv;
  bf16_t* act;
  unsigned* kmax;
};

DI unsigned pk_bf16(float lo, float hi) {
  f32x2 v = {lo, hi};
  bf2_t b = __builtin_convertvector(v, bf2_t);
  return __builtin_bit_cast(unsigned, b);
}
DI float bf2f(short s) { return __uint_as_float(((unsigned)(unsigned short)s) << 16); }
DI float fexp2(float x) { return __builtin_amdgcn_exp2f(x); }
DI float flog2(float x) { return __builtin_amdgcn_logf(x); }
DI int otid() { int t = threadIdx.x; asm volatile("" : "+v"(t)); return t; }
DI unsigned xb_xcc_id() { return (unsigned)__builtin_amdgcn_s_getreg((3 << 11) | 20) & 0xFu; }
DI float ssq_f(u64 v) { return (float)v * (1.f / 1048576.f); }
DI void ssq_add(u64* p, float part) { atomicAdd(p, (u64)(part * 1048576.f + 0.5f)); }
DI int crow(int i, int h) { return (i & 3) + 8 * (i >> 2) + 4 * h; }

constexpr int LST = 72;
constexpr int TILE_EL = 128 * LST;
constexpr int SMEM_BYTES = 4 * TILE_EL * 2;

template <bool SWAP, bool HALF>
DI void gemm_mainloop(const GemmDesc& d, int m0, int n0, bf16_t* smem, f32x16 (&acc)[2][2], int dry) {
  const int t = otid(), lane = t & 63, w = t >> 6, wm = w >> 1, wn = w & 1, r = lane & 31, hh = lane >> 5;
  const int lrow = t >> 3, lkc = t & 7;
  const bf16_t* ap[4]; const bf16_t* bp[4];
#pragma unroll
  for (int i = 0; i < 4; ++i) {
    int am = m0 + lrow + 32 * i; am = am < M ? am : M - 1;
    ap[i] = d.A + (size_t)am * d.lda + lkc * 8 + (d.a_grp ? (n0 / d.a_grp) * d.a_grp : 0);
    bp[i] = d.Bt + (size_t)(n0 + lrow + 32 * i) * d.ldb + lkc * 8;
  }
#pragma unroll
  for (int a = 0; a < 2; ++a)
#pragma unroll
    for (int b = 0; b < 2; ++b)
#pragma unroll
      for (int i = 0; i < 16; ++i) acc[a][b][i] = 0.f;
  u32x4 ra0[4], rb0[4], ra1[4], rb1[4];
  const int nk = d.K >> 6;
  const int lds_w = lrow * LST + lkc * 8;
  auto gl = [&](u32x4 (&ra)[4], u32x4 (&rb)[4], int ks) {
#pragma unroll
    for (int i = 0; i < 4; ++i) {
      ra[i] = *(const u32x4*)(ap[i] + (size_t)ks * d.a_cs);
      __builtin_amdgcn_sched_barrier(0);
      rb[i] = *(const u32x4*)(bp[i] + (size_t)ks * 64);
      __builtin_amdgcn_sched_barrier(0);
    }
  };
  auto lw = [&](const u32x4 (&ra)[4], const u32x4 (&rb)[4], int buf) {
    bf16_t* An = smem + buf * 2 * TILE_EL + lds_w; bf16_t* Bn = An + TILE_EL;
#pragma unroll
    for (int i = 0; i < 4; ++i) {
      *(u32x4*)(An + 32 * i * LST) = ra[i];
      *(u32x4*)(Bn + 32 * i * LST) = rb[i];
    }
  };
  bf16x8 fa[2][2], fb[2][2];
  auto ldf = [&](int buf, int kk, int set) {
    const bf16_t* Ab = smem + buf * 2 * TILE_EL + ((HALF ? 0 : wm * 64) + r) * LST + 8 * hh + kk * 16;
    const bf16_t* Bb = smem + buf * 2 * TILE_EL + TILE_EL + ((HALF ? w * 32 : wn * 64) + r) * LST + 8 * hh + kk * 16;
#pragma unroll
    for (int i = 0; i < 2; ++i) { fa[set][i] = *(const bf16x8*)(Ab + i * 32 * LST); if (!HALF || i == 0) fb[set][i] = *(const bf16x8*)(Bb + i * 32 * LST); }
  };
  auto mma = [&](int set) {
#pragma unroll
    for (int a = 0; a < 2; ++a)
#pragma unroll
      for (int b = 0; b < (HALF ? 1 : 2); ++b) {
        if (SWAP) acc[a][b] = MFMA32(fb[set][b], fa[set][a], acc[a][b]);
        else      acc[a][b] = MFMA32(fa[set][a], fb[set][b], acc[a][b]);
      }
  };
#define SB_ __builtin_amdgcn_sched_barrier(0)
  auto stage = [&](int cur, u32x4 (&ran)[4], u32x4 (&rbn)[4], int ks) {
    ldf(cur, 1, 1); SB_;
    mma(0); SB_;
    ldf(cur, 2, 0); SB_;
    lw(ran, rbn, cur ^ 1);
    gl(ran, rbn, (ks + 3 < nk) ? ks + 3 : nk - 1);
    SB_;
    mma(1); SB_;
    __syncthreads();
    ldf(cur, 3, 1); SB_;
    mma(0); SB_;
    ldf(cur ^ 1, 0, 0);
    SB_;
    mma(1); SB_;
    __syncthreads();
  };
  gl(ra0, rb0, 0);
  gl(ra1, rb1, 1);
  lw(ra0, rb0, 0);
  gl(ra0, rb0, 2);
  __syncthreads();
  ldf(0, 0, 0);
#pragma unroll 2
  for (int ks = 0; ks < nk; ks += 2) {
    stage(0, ra1, rb1, ks);
    stage(1, ra0, rb0, ks + 1);
  }
#undef SB_
}

constexpr int CS = 132;

DI float hsum32(float v) {
#pragma unroll
  for (int o = 16; o > 0; o >>= 1) v += __shfl_xor(v, o);
  return v;
}

DI void gemm_tile(const GemmDesc& d, int m0, int n0, bf16_t* smem, int dry) {
  const int t = otid(), lane = t & 63, w = t >> 6, wm = w >> 1, wn = w & 1, r = lane & 31, hh = lane >> 5;
  float* Ct = (float*)smem;
  f32x16 acc[2][2];
  const bool vtile = (d.epi == EPI_STORE) && (n0 >= d.n1end) && (n0 < d.nvend);
  float* rs_s = (float*)((unsigned char*)smem + 128 * CS * 4);
  u64 myss = 0ull;
  if (d.ssq_in && t < 128) { const int mr = (m0 + t) < M ? (m0 + t) : M - 1; myss = d.ssq_in[mr]; }
  if (vtile) {
    gemm_mainloop<false, false>(d, m0, n0, smem, acc, dry);
    if (dry) return;
    if (t < 128) rs_s[t] = rsqrtf(ssq_f(myss) * d.inv_dim + EPS);
#pragma unroll
    for (int a = 0; a < 2; ++a)
#pragma unroll
      for (int g = 0; g < 4; ++g) {
        const int ml = wm * 64 + a * 32 + 8 * g + 4 * hh;
#pragma unroll
        for (int b = 0; b < 2; ++b) {
          f32x4 o;
#pragma unroll
          for (int j = 0; j < 4; ++j) o[j] = acc[a][b][4 * g + j];
          *(f32x4*)(Ct + (wn * 64 + b * 32 + r) * CS + ml) = o;
        }
      }
    __syncthreads();
#pragma unroll 4
    for (int pass = 0; pass < 16; ++pass) {
      const int nl = pass * 8 + (t >> 5), c4 = t & 31, mb = m0 + c4 * 4;
      if (mb < M) {
        const f32x4 v = *(const f32x4*)(Ct + nl * CS + c4 * 4);
        const f32x4 rv = *(const f32x4*)(rs_s + c4 * 4);
        const int nv = n0 - d.n1end + nl, head = nv >> 6, dd = nv & 63;
        const int bb = mb / L, pos = mb - bb * L;
        u32x2 o; o[0] = pk_bf16(v[0] * rv[0], v[1] * rv[1]); o[1] = pk_bf16(v[2] * rv[2], v[3] * rv[3]);
        *(u32x2*)(d.vt + ((size_t)((bb * NH + head) * 64 + dd)) * LP + pos) = o;
      }
    }
    __syncthreads();
    return;
  }
  const bool half = false;
  if (half) gemm_mainloop<true, true>(d, m0, n0, smem, acc, dry);
  else      gemm_mainloop<true, false>(d, m0, n0, smem, acc, dry);
  if (dry) return;
  u32x2 hpre[16];
  if (d.epi == EPI_RESID) {
#pragma unroll
    for (int pass = 0; pass < 16; ++pass) {
      int m = m0 + pass * 8 + (t >> 5); m = m < M ? m : M - 1;
      hpre[pass] = *(const u32x2*)(d.hb + (size_t)m * D + d.c_off + n0 + (t & 31) * 4);
    }
  } else if (t < 128) {
    rs_s[t] = rsqrtf(ssq_f(myss) * d.inv_dim + EPS);
  }
  if (half) {
#pragma unroll
    for (int a = 0; a < 2; ++a)
#pragma unroll
      for (int g = 0; g < 4; ++g) {
        f32x4 o;
#pragma unroll
        for (int j = 0; j < 4; ++j) o[j] = acc[a][0][4 * g + j];
        *(f32x4*)(Ct + (a * 32 + r) * CS + w * 32 + 8 * g + 4 * hh) = o;
      }
  } else {
#pragma unroll
    for (int a = 0; a < 2; ++a)
#pragma unroll
      for (int b = 0; b < 2; ++b)
#pragma unroll
        for (int g = 0; g < 4; ++g) {
          f32x4 o;
#pragma unroll
          for (int j = 0; j < 4; ++j) o[j] = acc[a][b][4 * g + j];
          *(f32x4*)(Ct + (wm * 64 + a * 32 + r) * CS + wn * 64 + b * 32 + 8 * g + 4 * hh) = o;
        }
  }
  __syncthreads();
  if (d.epi == EPI_RESID) {
#pragma unroll
    for (int pass = 0; pass < 16; ++pass) {
      const int row = pass * 8 + (t >> 5), c4 = t & 31, m = m0 + row;
      float part = 0.f;
      if (m < M) {
        const f32x4 v = *(const f32x4*)(Ct + row * CS + c4 * 4);
        const int n = d.c_off + n0 + c4 * 4;
        f32x4 hv;
        hv[0] = __uint_as_float(hpre[pass][0] << 16); hv[1] = __uint_as_float(hpre[pass][0] & 0xffff0000u);
        hv[2] = __uint_as_float(hpre[pass][1] << 16); hv[3] = __uint_as_float(hpre[pass][1] & 0xffff0000u);
#pragma unroll
        for (int j = 0; j < 4; ++j) { hv[j] += v[j]; part += hv[j] * hv[j]; }
        u32x2 o; o[0] = pk_bf16(hv[0], hv[1]); o[1] = pk_bf16(hv[2], hv[3]);
        *(u32x2*)(d.hb + (size_t)m * D + n) = o;
      }
      part = hsum32(part);
      if (c4 == 0 && m < M) ssq_add(d.ssq_out + m, part);
    }
  } else if (d.epi == EPI_SWIGLU) {
#pragma unroll
    for (int pass = 0; pass < 8; ++pass) {
      const int row = pass * 16 + (t >> 4), c4 = t & 15, m = m0 + row;
      if (m < M) {
        const float rs = rs_s[row];
        const int ac = c4 * 4, cb = (ac >> 5) * 64 + (ac & 31);
        const f32x4 gt = *(const f32x4*)(Ct + row * CS + cb);
        const f32x4 up = *(const f32x4*)(Ct + row * CS + cb + 32);
        float v[4];
#pragma unroll
        for (int j = 0; j < 4; ++j) {
          const float gg = gt[j] * rs;
          v[j] = gg * __builtin_amdgcn_rcpf(1.f + fexp2(-gg * 1.44269504f)) * (up[j] * rs);
        }
        u32x2 o; o[0] = pk_bf16(v[0], v[1]); o[1] = pk_bf16(v[2], v[3]);
        *(u32x2*)(d.act + (size_t)m * DFF + (n0 >> 1) + ac) = o;
      }
    }
  } else if (n0 < d.n1end) {
    bf16_t* dst; int ld, nb;
    if (n0 < d.n0end) { dst = d.d0; ld = d.ld0; nb = n0; } else { dst = d.d1; ld = d.ld1; nb = n0 - d.n0end; }
    unsigned* kq = (d.kmax && n0 >= d.n0end) ? d.kmax : nullptr;
    const int mlast = (m0 + 127) < M ? (m0 + 127) : M - 1;
    const bool onebatch = (m0 / L) == (mlast / L);
    float kmx = 0.f;
    u64* sq = nullptr;
    if (d.ssq_a) { if (n0 < d.ssq_a_end) sq = d.ssq_a; else if (n0 < d.ssq_b_end) sq = d.ssq_b; }
#pragma unroll
    for (int pass = 0; pass < 16; ++pass) {
      const int row = pass * 8 + (t >> 5), c4 = t & 31, m = m0 + row;
      float part = 0.f, kpart = 0.f;
      if (m < M) {
        const float rs = rs_s[row];
        f32x4 v = *(const f32x4*)(Ct + row * CS + c4 * 4);
#pragma unroll
        for (int j = 0; j < 4; ++j) { v[j] *= rs; part += v[j] * v[j]; }
        u32x2 o; o[0] = pk_bf16(v[0], v[1]); o[1] = pk_bf16(v[2], v[3]);
        *(u32x2*)(dst + (size_t)m * ld + nb + c4 * 4) = o;
        if (kq) {
          const float a0 = __uint_as_float(o[0] << 16), a1 = __uint_as_float(o[0] & 0xffff0000u);
          const float a2 = __uint_as_float(o[1] << 16), a3 = __uint_as_float(o[1] & 0xffff0000u);
          kpart = a0 * a0 + a1 * a1 + a2 * a2 + a3 * a3;
        }
      }
      if (kq) {
        float kpart2 = kpart;
#pragma unroll
        for (int o = 8; o > 0; o >>= 1) kpart2 += __shfl_xor(kpart2, o);
        if (onebatch) kmx = fmaxf(kmx, kpart2);
        else if ((c4 & 15) == 0 && m < M) atomicMax(kq + (m / L) * NH + ((nb + c4 * 4) >> 6), __float_as_uint(kpart2));
      }
      if (sq) {
        part = hsum32(part);
        if (c4 == 0 && m < M) ssq_add(sq + m, part);
      }
    }
    if (kq && onebatch && ((t & 15) == 0)) atomicMax(kq + (m0 / L) * NH + ((nb + (t & 31) * 4) >> 6), __float_as_uint(kmx));
  } else {
#pragma unroll
    for (int pass = 0; pass < 2; ++pass) {
      const int row = pass * 64 + (t >> 2), c4 = t & 3, m = m0 + row;
      if (m < M) {
        const float rs = rs_s[row];
        const f32x4 v = *(const f32x4*)(Ct + row * CS + c4 * 4);
        f32x4 o;
#pragma unroll
        for (int j = 0; j < 4; ++j) {
          const float x = v[j] * rs + d.bfv[c4 * 4 + j];
          o[j] = fminf(x, 0.f) - 0.69314718f * flog2(1.f + fexp2(-fabsf(x) * 1.44269504f));
        }
        *(f32x4*)(d.flog + (size_t)m * 16 + c4 * 4) = o;
      }
    }
  }
  __syncthreads();
}

DI void gemm_phase(const GemmDesc& d, bf16_t* smem, int dry = 0) {
  const int nM = (M + 127) / 128, nN = d.N >> 7;
  const int x = blockIdx.x & 7, slot = blockIdx.x >> 3, nslots = gridDim.x >> 3;
  const int cx = (nM - x + 7) >> 3, total = cx * nN;
  for (int i = slot; i < total; i += nslots) {
    const int g = i / (8 * nN), j = i - g * 8 * nN;
    const int gm = (cx - g * 8) < 8 ? (cx - g * 8) : 8;
    const int mt = (g * 8 + j % gm) * 8 + x, nt = j / gm;
    gemm_tile(d, mt * 128, nt * 128, smem, dry);
  }
}

struct AttnArgs { bf16_t* q; int ldq, hs; const bf16_t* k; const bf16_t* kr; const bf16_t* vt; const float* Fh; unsigned* ctr; const unsigned* kmax; };
constexpr int VST = 68;

template <int MODE>
DI void attn_phase(const AttnArgs& aa, bf16_t* smem, int dry = 0) {
  constexpr int DQK = (MODE == 1) ? 96 : 64, NKS = DQK / 16, KST = DQK + 8;
  constexpr int KCH = (MODE == 1) ? 3 : 2;
  const int t = otid(), lane = t & 63, w = t >> 6, r = lane & 31, hh = lane >> 5;
  bf16_t* Kl = smem;
  bf16_t* Vl = smem + 2 * 64 * KST;
  float* Fl = (float*)(Vl + 2 * 64 * VST);
  int* s_item = (int*)(Fl + 128);
  int* s_flag = s_item + 4;
  const int total = NB * NH * 65;
  const int lkey = t >> 2, lsub = t & 3;
  constexpr float LOG2E = 1.44269504f;
  const float c2 = (MODE == 1 ? 0.10206207f : 0.125f) * LOG2E;

  const int myx = (int)(xb_xcc_id() & 7u);
  int qx = 0;
  for (;;) {
    __syncthreads();
    if (t == 0) {
      int v = -1;
      while (qx < 8) {
        const int xx = (myx + qx) & 7;
        const int got = (int)atomicAdd(aa.ctr + xx, 1u);
        if (got < total / 8) { v = got * 8 + xx; break; }
        ++qx;
      }
      s_item[0] = v; s_item[1] = qx;
    }
    __syncthreads();
    const int enc = s_item[0]; qx = s_item[1];
    if (enc < 0) break;
    const int xx_ = enc & 7, idx = enc >> 3;
    const int qt = 64 - idx % 65, bh = (idx / 65) * 8 + xx_, b = bh >> 4, hd = bh & 15;
    const int q0 = qt * 128;
    const int posq = q0 + w * 32 + r;
    const bool qvalid = posq < L;
    const int pq = qvalid ? posq : L - 1;
    bf16_t* qptr = aa.q + (size_t)(b * L + pq) * aa.ldq + hd * aa.hs;
    bf16x8 qf[NKS];
#pragma unroll
    for (int ks = 0; ks < NKS; ++ks) qf[ks] = *(const bf16x8*)(qptr + ks * 16 + 8 * hh);
    if (MODE == 1) {
#pragma unroll
      for (int j = 0; j < 8; j += 2) {
        float o1[2], o2[2];
#pragma unroll
        for (int e = 0; e < 2; ++e) {
          const int i = 8 * hh + j + e;
          const float inv = fexp2(-(float)i * 0.83048202f);
          const float ang = (float)pq * inv;
          const float n = rintf(ang * 0.15915494f);
          float rr = fmaf(-n, 6.2831855f, ang); rr = fmaf(-n, -1.7484555e-7f, rr);
          const float cs = __cosf(rr), sn = __sinf(rr);
          const float x1 = bf2f(qf[NKS - 2][j + e]), x2 = bf2f(qf[NKS - 1][j + e]);
          o1[e] = x1 * cs - x2 * sn; o2[e] = x2 * cs + x1 * sn;
        }
        const unsigned p1 = pk_bf16(o1[0], o1[1]), p2 = pk_bf16(o2[0], o2[1]);
        qf[NKS - 2][j] = (short)(p1 & 0xffff); qf[NKS - 2][j + 1] = (short)(p1 >> 16);
        qf[NKS - 1][j] = (short)(p2 & 0xffff); qf[NKS - 1][j + 1] = (short)(p2 >> 16);
      }
    }
    float Bq = 0.f;
    if (MODE == 2) {
      float qq = 0.f;
#pragma unroll
      for (int ks = 0; ks < NKS; ++ks)
#pragma unroll
        for (int j = 0; j < 8; ++j) { const float x = bf2f(qf[ks][j]); qq += x * x; }
      qq += __shfl_xor(qq, 32);
      Bq = sqrtf(qq) * sqrtf(__uint_as_float(aa.kmax[bh])) * (c2 * 1.02f);
    }

    int kt = (q0 + 127) >> 6; if (kt > (L - 1) >> 6) kt = (L - 1) >> 6;
    const int wqmax = q0 + w * 32 + 31;
    const bf16_t* vsrc = aa.vt + ((size_t)(bh * 64 + lkey)) * LP + lsub * 8;
    u32x4 rkA[KCH], rvA[2], rkB[KCH], rvB[2]; float rfA = 0.f, rfB = 0.f;
    auto gload = [&](u32x4 (&rk)[KCH], u32x4 (&rv)[2], float& rf, int ktile) {
      int kp = ktile * 64 + lkey; kp = kp < L ? kp : L - 1;
      const size_t mk = (size_t)(b * L + kp);
      const bf16_t* ks_ = aa.k + mk * D + hd * 64 + lsub * 8;
      rk[0] = *(const u32x4*)ks_; __builtin_amdgcn_sched_barrier(0);
      rk[1] = *(const u32x4*)(ks_ + 32); __builtin_amdgcn_sched_barrier(0);
      if (MODE == 1) { rk[KCH - 1] = *(const u32x4*)(aa.kr + mk * 32 + lsub * 8); __builtin_amdgcn_sched_barrier(0); }
      rv[0] = *(const u32x4*)(vsrc + ktile * 64); __builtin_amdgcn_sched_barrier(0);
      rv[1] = *(const u32x4*)(vsrc + ktile * 64 + 32); __builtin_amdgcn_sched_barrier(0);
      if (MODE == 2) { rf = aa.Fh[(size_t)bh * LP + ktile * 64 + (t & 63)]; __builtin_amdgcn_sched_barrier(0); }
    };
    auto lstore = [&](const u32x4 (&rk)[KCH], const u32x4 (&rv)[2], const float rf, int buf) {
      bf16_t* kd = Kl + buf * 64 * KST + lkey * KST + lsub * 8;
      *(u32x4*)kd = rk[0]; *(u32x4*)(kd + 32) = rk[1];
      if (MODE == 1) *(u32x4*)(kd + 64) = rk[KCH - 1];
      bf16_t* vd = Vl + buf * 64 * VST + lkey * VST + lsub * 8;
      u32x2 lo, hi;
      lo[0] = rv[0][0]; lo[1] = rv[0][1]; hi[0] = rv[0][2]; hi[1] = rv[0][3];
      *(u32x2*)vd = lo; *(u32x2*)(vd + 4) = hi;
      lo[0] = rv[1][0]; lo[1] = rv[1][1]; hi[0] = rv[1][2]; hi[1] = rv[1][3];
      *(u32x2*)(vd + 32) = lo; *(u32x2*)(vd + 36) = hi;
      if (MODE == 2 && t < 64) Fl[buf * 64 + t] = -rf * LOG2E;
    };
    gload(rkA, rvA, rfA, kt); gload(rkB, rvB, rfB, kt > 0 ? kt - 1 : 0); lstore(rkA, rvA, rfA, 0);

    f32x16 oacc[2];
#pragma unroll
    for (int i = 0; i < 16; ++i) { oacc[0][i] = 0.f; oacc[1][i] = 0.f; }
    float mrun = -1e30f, lsum = 0.f, Rrun = 0.f, nfnext = 3.0e38f;
    auto iter = [&](auto PARC) -> bool {
      constexpr int PAR = decltype(PARC)::value;
      if (MODE != 1) {
        const int dn = (MODE == 0) ? ((!qvalid) || (Rrun < -120.f)) : ((!qvalid) || (Bq + nfnext < mrun - 150.f));
        const int wd = __all(dn) ? 1 : 0;
        if (lane == 0) s_flag[PAR * 4 + w] = wd;
        __syncthreads();
        const int f0 = s_flag[PAR * 4 + 0], f1 = s_flag[PAR * 4 + 1], f2 = s_flag[PAR * 4 + 2], f3 = s_flag[PAR * 4 + 3];
        if (f0 & f1 & f2 & f3) return true;
      } else {
        __syncthreads();
      }
      constexpr int buf = PAR;
      if (MODE == 2) { const float fl = aa.Fh[(size_t)bh * LP + (kt > 0 ? kt * 64 - 1 : 0)]; __builtin_amdgcn_sched_barrier(0); nfnext = (kt > 0) ? -fl * LOG2E : 0.f; }
      { const int kpre = kt > 1 ? kt - 2 : 0; if (PAR == 0) gload(rkA, rvA, rfA, kpre); else gload(rkB, rvB, rfB, kpre); }
      if (kt * 64 <= wqmax && dry < 2) {
        const bf16_t* Kb = Kl + buf * 64 * KST; const bf16_t* Vb = Vl + buf * 64 * VST;
        f32x16 s[2];
#pragma unroll
        for (int i = 0; i < 16; ++i) { s[0][i] = 0.f; s[1][i] = 0.f; }
        if (MODE == 0) {
#pragma unroll
          for (int ks = 0; ks < NKS; ++ks) {
            const bf16x8 a0 = *(const bf16x8*)(Kb + r * KST + ks * 16 + 8 * hh);
            const bf16x8 a1 = *(const bf16x8*)(Kb + (32 + r) * KST + ks * 16 + 8 * hh);
            s[0] = MFMA32(a0, qf[ks], s[0]);
            s[1] = MFMA32(a1, qf[ks], s[1]);
          }
        } else {
          bf16x8 kf0[NKS], kf1[NKS];
#pragma unroll
          for (int ks = 0; ks < NKS; ++ks) kf0[ks] = *(const bf16x8*)(Kb + r * KST + ks * 16 + 8 * hh);
#pragma unroll
          for (int ks = 0; ks < NKS; ++ks) kf1[ks] = *(const bf16x8*)(Kb + (32 + r) * KST + ks * 16 + 8 * hh);
          __builtin_amdgcn_sched_barrier(0);
#pragma unroll
          for (int ks = 0; ks < NKS; ++ks) s[0] = MFMA32(kf0[ks], qf[ks], s[0]);
#pragma unroll
          for (int ks = 0; ks < NKS; ++ks) s[1] = MFMA32(kf1[ks], qf[ks], s[1]);
          __builtin_amdgcn_sched_barrier(0);
        }
        const int kbase = kt * 64 + 4 * hh;
        u32x4 vfr[2][2];
        auto ldv = [&](int j) {
#pragma unroll
          for (int st = 0; st < 2; ++st)
#pragma unroll
            for (int dt = 0; dt < 2; ++dt) {
              const bf16_t* vp = Vb + (dt * 32 + r) * VST + j * 32 + 16 * st + 4 * hh;
              const u32x2 lo = *(const u32x2*)vp, hi = *(const u32x2*)(vp + 8);
              vfr[st][dt][0] = lo[0]; vfr[st][dt][1] = lo[1]; vfr[st][dt][2] = hi[0]; vfr[st][dt][3] = hi[1];
            }
          __builtin_amdgcn_sched_barrier(0);
        };
        auto pvm = [&](int j) {
#pragma unroll
          for (int st = 0; st < 2; ++st) {
            u32x4 pp;
#pragma unroll
            for (int q = 0; q < 4; ++q) pp[q] = pk_bf16(s[j][8 * st + 2 * q], s[j][8 * st + 2 * q + 1]);
            const bf16x8 pb = __builtin_bit_cast(bf16x8, pp);
#pragma unroll
            for (int dt = 0; dt < 2; ++dt) oacc[dt] = MFMA32(__builtin_bit_cast(bf16x8, vfr[st][dt]), pb, oacc[dt]);
          }
        };
        auto pv = [&](int j) { ldv(j); pvm(j); };
        if (MODE == 0) {
          float Gs[8]; float lk[2][16];
#pragma unroll
          for (int j = 0; j < 2; ++j)
#pragma unroll
            for (int g = 0; g < 4; ++g) {
              float gsum = 0.f;
#pragma unroll
              for (int e = 0; e < 4; ++e) {
                const int i = 4 * g + e;
                const float z = s[j][i] * 0.125f;
                const float sp = fmaxf(z, 0.f) + 0.69314718f * flog2(1.f + fexp2(-fabsf(z) * LOG2E));
                const bool valid = (kbase + j * 32 + 8 * g + e) < posq;
                const float l = valid ? -sp : 0.f;
                lk[j][i] = l; gsum += l;
                s[j][i] = z - sp;
              }
              Gs[j * 4 + g] = gsum;
            }
          float inc[9]; float run = 0.f; inc[8] = 0.f;
#pragma unroll
          for (int q = 7; q >= 0; --q) { run += Gs[q]; inc[q] = run; }
          float recv[8];
#pragma unroll
          for (int q = 0; q < 8; ++q) recv[q] = __shfl_xor(inc[q + 1] + (hh ? Gs[q] : 0.f), 32);
          const float ptot = __shfl_xor(run, 32);
#pragma unroll
          for (int j = 0; j < 2; ++j)
#pragma unroll
            for (int g = 0; g < 4; ++g) {
              const int q = j * 4 + g;
              float later = Rrun + inc[q + 1] + recv[q];
#pragma unroll
              for (int e = 3; e >= 0; --e) {
                const int i = 4 * g + e;
                const bool valid = (kbase + j * 32 + 8 * g + e) < posq;
                const float a = valid ? fexp2((s[j][i] + later) * LOG2E) : 0.f;
                later += lk[j][i];
                s[j][i] = a;
              }
            }
          Rrun += run + ptot;
        } else {
          const bool diag = kt * 64 + 63 > q0 + w * 32;
          const int dq = posq - kbase;
#pragma unroll
          for (int j = 0; j < 2; ++j) {
            ldv(j);
            if (MODE == 2) {
#pragma unroll
              for (int g = 0; g < 4; ++g) {
                const f32x4 nf = *(const f32x4*)(Fl + buf * 64 + j * 32 + 8 * g + 4 * hh);
#pragma unroll
                for (int e = 0; e < 4; ++e) s[j][4 * g + e] = fmaf(s[j][4 * g + e], c2, nf[e]);
              }
            }
            if (diag) {
              asm volatile("" ::: "memory");
#pragma unroll
              for (int i = 0; i < 16; ++i) s[j][i] = (j * 32 + 8 * (i >> 2) + (i & 3)) <= dq ? s[j][i] : -INFINITY;
            }
            float mt = fmaxf(s[j][0], s[j][1]);
#pragma unroll
            for (int i = 2; i < 16; ++i) mt = fmaxf(mt, s[j][i]);
            mt = fmaxf(mt, __shfl_xor(mt, 32));
            if (MODE == 1) mt *= c2;
            const float cand = fmaxf(mrun, mt);
            if (__any(cand > mrun + 8.f)) {
              const float alpha = fexp2(mrun - cand);
              mrun = cand; lsum *= alpha;
#pragma unroll
              for (int i = 0; i < 16; ++i) { oacc[0][i] *= alpha; oacc[1][i] *= alpha; }
            }
            const float nm = -mrun;
#pragma unroll
            for (int i = 0; i < 16; ++i) {
              const float p = (MODE == 1) ? fexp2(fmaf(s[j][i], c2, nm)) : fexp2(s[j][i] + nm);
              lsum += p; s[j][i] = p;
            }
            pvm(j);
          }
        }
        if (MODE == 0) { pv(0); pv(1); }
      }
      { if (PAR == 0) lstore(rkB, rvB, rfB, 1); else lstore(rkA, rvA, rfA, 0); }
      --kt;
      return kt < 0;
    };
    for (;;) {
      if (iter(std::integral_constant<int, 0>{})) break;
      if (iter(std::integral_constant<int, 1>{})) break;
    }
    float inv = 1.f;
    if (MODE != 0) { const float lt = lsum + __shfl_xor(lsum, 32); inv = 1.f / lt; }
    if (qvalid && !dry) {
#pragma unroll
      for (int dt = 0; dt < 2; ++dt)
#pragma unroll
        for (int g = 0; g < 4; ++g) {
          u32x2 o;
          o[0] = pk_bf16(oacc[dt][4 * g + 0] * inv, oacc[dt][4 * g + 1] * inv);
          o[1] = pk_bf16(oacc[dt][4 * g + 2] * inv, oacc[dt][4 * g + 3] * inv);
          *(u32x2*)(qptr + dt * 32 + 8 * g + 4 * hh) = o;
        }
    }
  }
}

DI void prep_tile(const PrepJob& j, int lt, float* tl  ) {
  const int t = otid();
  const int kt = lt / j.ntn, nt = lt - kt * j.ntn;
  const int k0 = kt * 64, n0 = nt * 64;
  __syncthreads();
  {
    const int n4 = n0 + (t & 15) * 4, kq = t >> 4;
    const bool nv = n4 < j.Njob;
    const int ns = nv ? (n4 / j.sblk) * j.sstride + j.soff + n4 % j.sblk : 0;
    f32x4 cs = {1.f, 1.f, 1.f, 1.f};
    if (nv && j.colscale) cs = *(const f32x4*)(j.colscale + ns);
    f32x4 v[4]; float gk[4];
#pragma unroll
    for (int i = 0; i < 4; ++i) {
      const int k = kq + 16 * i;
      v[i] = nv ? *(const f32x4*)(j.src + (size_t)(k0 + k) * j.ld_src + ns) : (f32x4){0.f, 0.f, 0.f, 0.f};
      gk[i] = j.gain ? j.gain[k0 + k] : 1.f;
    }
#pragma unroll
    for (int i = 0; i < 4; ++i) {
      const int k = kq + 16 * i;
#pragma unroll
      for (int e = 0; e < 4; ++e) tl[k * 65 + (t & 15) * 4 + e] = v[i][e] * cs[e] * gk[i];
    }
  }
  __syncthreads();
#pragma unroll
  for (int c = t; c < 512; c += 256) {
    const int nl = c >> 3, kc = c & 7;
    const int n = n0 + nl;
    if (n < j.Npad) {
      const int drow = (n / j.dblk) * j.dstride + j.doff + n % j.dblk;
      u32x4 o;
#pragma unroll
      for (int q = 0; q < 4; ++q) o[q] = pk_bf16(tl[(kc * 8 + 2 * q) * 65 + nl], tl[(kc * 8 + 2 * q + 1) * 65 + nl]);
      *(u32x4*)(j.dst + (size_t)drow * j.ld_dst + k0 + kc * 8) = o;
    }
  }
}

constexpr int PT = 24;
DI void pool_tile(const Params& p, int tile, float* s_rstd  ) {
  const int t = otid(), lane = t & 63, w = t >> 6;
  const int b = tile / (L / PT), p0 = (tile - b * (L / PT)) * PT;
  const float* x = p.in[0]; const float* meta = p.in[1]; const float* gmix = p.in[2];
  auto rowptr = [&](int pos) -> const float* {
    return pos < NMETA ? meta + (size_t)pos * D : x + ((size_t)b * SEQ + (pos - NMETA)) * D;
  };
  __syncthreads();
  for (int j = w; j < PT + 15; j += 4) {
    const int pj = p0 - 15 + j;
    if (pj >= 0) {
      const float* rp = rowptr(pj);
      float ss = 0.f;
#pragma unroll
      for (int i = 0; i < 4; ++i) { const f32x4 v = *(const f32x4*)(rp + (lane + 64 * i) * 4); ss += v[0] * v[0] + v[1] * v[1] + v[2] * v[2] + v[3] * v[3]; }
#pragma unroll
      for (int o = 32; o > 0; o >>= 1) ss += __shfl_xor(ss, o);
      if (lane == 0) s_rstd[j] = rsqrtf(ss * (1.f / D) + EPS);
    }
  }
  __syncthreads();
  const int c = t * 4, win = 2 << (t >> 6);
  const f32x4 gn = *(const f32x4*)(gmix + c);
  auto aval = [&](int pos) -> f32x4 {
    const f32x4 v = *(const f32x4*)(rowptr(pos) + c);
    const float rs = s_rstd[pos - (p0 - 15)];
    f32x4 o; o[0] = v[0] * rs * gn[0]; o[1] = v[1] * rs * gn[1]; o[2] = v[2] * rs * gn[2]; o[3] = v[3] * rs * gn[3];
    return o;
  };
  f32x4 s = {0.f, 0.f, 0.f, 0.f};
  for (int j = p0 - win + 1; j < p0; ++j) if (j >= 0) { const f32x4 a = aval(j); s += a; }
#pragma unroll 1
  for (int pc = p0; pc < p0 + PT; pc += 8) {
    f32x4 raw[8], oldv[8];
#pragma unroll
    for (int i = 0; i < 8; ++i) {
      raw[i] = *(const f32x4*)(rowptr(pc + i) + c);
      const int po = pc + i - win + 1;
      oldv[i] = *(const f32x4*)(rowptr(po >= 0 ? po : 0) + c);
    }
#pragma unroll
    for (int i = 0; i < 8; ++i) {
      const int pos = pc + i;
      const size_t m = (size_t)b * L + pos;
      { u32x2 hr; hr[0] = pk_bf16(raw[i][0], raw[i][1]); hr[1] = pk_bf16(raw[i][2], raw[i][3]); *(u32x2*)(p.hb + m * D + c) = hr; }
      const float rs = s_rstd[pos - (p0 - 15)];
      f32x4 a; a[0] = raw[i][0] * rs * gn[0]; a[1] = raw[i][1] * rs * gn[1]; a[2] = raw[i][2] * rs * gn[2]; a[3] = raw[i][3] * rs * gn[3];
      s += a;
      const int cnt = (pos + 1) < win ? (pos + 1) : win;
      const float ic = 1.f / (float)cnt;
      u32x2 o; o[0] = pk_bf16(s[0] * ic - a[0], s[1] * ic - a[1]); o[1] = pk_bf16(s[2] * ic - a[2], s[3] * ic - a[3]);
      *(u32x2*)(p.R + m * D + c) = o;
      const int po = pos - win + 1;
      if (po >= 0) {
        const float ro = s_rstd[po - (p0 - 15)];
        s[0] -= oldv[i][0] * ro * gn[0]; s[1] -= oldv[i][1] * ro * gn[1]; s[2] -= oldv[i][2] * ro * gn[2]; s[3] -= oldv[i][3] * ro * gn[3];
      }
    }
  }
}

DI void zero_vt_pad(bf16_t* vt) {
  const int total = NB * NH * 64 * 6;
  for (int i = blockIdx.x * NTHREADS + threadIdx.x; i < total; i += gridDim.x * NTHREADS) {
    const int row = i / 6, c = i - row * 6;
    u32x4 z = {0u, 0u, 0u, 0u};
    *(u32x4*)(vt + (size_t)row * LP + L + c * 8) = z;
  }
}

DI void kr_rope_phase(const Params& p) {
  const int total = M * 16;
  for (int i = blockIdx.x * NTHREADS + threadIdx.x; i < total; i += gridDim.x * NTHREADS) {
    const int m = i >> 4, e = i & 15;
    const int pos = m % L;
    const float x1 = bf2f((short)p.down[(size_t)m * 768 + 640 + e]), x2 = bf2f((short)p.down[(size_t)m * 768 + 656 + e]);
    const float inv = fexp2(-(float)e * 0.83048202f);
    const float ang = (float)pos * inv;
    const float n = rintf(ang * 0.15915494f);
    float rr = fmaf(-n, 6.2831855f, ang); rr = fmaf(-n, -1.7484555e-7f, rr);
    const float cs = __cosf(rr), sn = __sinf(rr);
    const unsigned o1 = pk_bf16(x1 * cs - x2 * sn, 0.f), o2 = pk_bf16(x2 * cs + x1 * sn, 0.f);
    p.kr[(size_t)m * 32 + e] = (bf16_t)(o1 & 0xffff);
    p.kr[(size_t)m * 32 + 16 + e] = (bf16_t)(o2 & 0xffff);
  }
}

DI void fox_scan_phase(const Params& p, float* sm  ) {
  const int t = otid();
  constexpr int SEG = 36, NSEG = L / SEG;
  for (int bh = blockIdx.x; bh < NB * NH; bh += gridDim.x) {
    const int b = bh >> 4, hd = bh & 15;
    __syncthreads();
    float v[SEG]; float tot = 0.f;
    if (t < NSEG) {
      const float* src = p.flog + ((size_t)b * L + t * SEG) * 16 + hd;
#pragma unroll
      for (int i = 0; i < SEG; ++i) { tot += src[(size_t)i * 16]; v[i] = tot; }
      sm[t] = tot;
    }
    __syncthreads();
    if (t == 0) { float run = 0.f; for (int i = 0; i < NSEG; ++i) { const float x = sm[i]; sm[i] = run; run += x; } }
    __syncthreads();
    if (t < NSEG) {
      const float base = sm[t];
      float* dst = p.Fh + (size_t)bh * LP + t * SEG;
#pragma unroll
      for (int i = 0; i < SEG; ++i) dst[i] = base + v[i];
    }
  }
}

DI void final_phase(const Params& p) {
  const u64* ssq = p.ssq + 7 * (size_t)M; const float* g = p.in[20];
  const int total = NB * SEQ * (D / 4), stride = gridDim.x * NTHREADS;
  for (int i0 = blockIdx.x * NTHREADS + threadIdx.x; i0 < total; i0 += 4 * stride) {
    u32x2 hr[4]; u64 sq[4];
#pragma unroll
    for (int u = 0; u < 4; ++u) {
      const int i = (i0 + u * stride) < total ? (i0 + u * stride) : i0;
      const int row = i >> 8, c = (i & 255) * 4;
      const int b = row / SEQ, sx = row - b * SEQ;
      const size_t m = (size_t)b * L + NMETA + sx;
      hr[u] = *(const u32x2*)(p.hb + m * D + c); sq[u] = ssq[m];
    }
#pragma unroll
    for (int u = 0; u < 4; ++u) {
      const int i = i0 + u * stride;
      if (i < total) {
        const int row = i >> 8, c = (i & 255) * 4;
        const f32x4 gv = *(const f32x4*)(g + c);
        const float rs = rsqrtf(ssq_f(sq[u]) * (1.f / D) + EPS);
        f32x4 o;
        o[0] = __uint_as_float(hr[u][0] << 16) * rs * gv[0]; o[1] = __uint_as_float(hr[u][0] & 0xffff0000u) * rs * gv[1];
        o[2] = __uint_as_float(hr[u][1] << 16) * rs * gv[2]; o[3] = __uint_as_float(hr[u][1] & 0xffff0000u) * rs * gv[3];
        *(f32x4*)(p.out + (size_t)row * D + c) = o;
      }
    }
  }
}

constexpr size_t R_K_SB = (size_t)M * 1024, R_VT_SB = (size_t)M * 2048;
constexpr size_t R_K_MLA = (size_t)M * 1536, R_VT_MLA = (size_t)M * 2560;

DI GemmDesc make_desc(const Params& p, int gi) {
  GemmDesc d;
  d.A = p.hb; d.Bt = nullptr; d.lda = D; d.a_cs = 64; d.ldb = D; d.K = D; d.N = D; d.epi = EPI_RESID; d.a_grp = 0;
  d.ssq_in = nullptr; d.inv_dim = 1.f / D; d.h = p.h; d.hb = p.hb; d.ssq_out = nullptr; d.c_off = 0;
  d.d0 = nullptr; d.ld0 = D; d.n0end = 0; d.d1 = nullptr; d.ld1 = D; d.n1end = 0; d.vt = nullptr; d.nvend = 0;
  d.ssq_a = nullptr; d.ssq_a_end = 0; d.ssq_b = nullptr; d.ssq_b_end = 0; d.flog = nullptr; d.bfv = nullptr; d.act = nullptr; d.kmax = nullptr;
  u64* ssq = p.ssq;
  if (gi < 4) {
    d.A = p.R; d.a_grp = 256; d.Bt = p.w_pool; d.ldb = 256; d.K = 256; d.N = 1024; d.ssq_out = ssq;
  } else if (gi < 12) {
    const int l = (gi - 4) >> 1;
    if (((gi - 4) & 1) == 0) {
      d.Bt = p.w_gu + (size_t)l * 5632 * 1024; d.N = 5632; d.epi = EPI_SWIGLU; d.ssq_in = ssq + (size_t)(2 * l) * M; d.act = p.R;
    } else {
      d.A = p.R; d.lda = DFF; d.K = DFF; d.Bt = p.w_dn + (size_t)l * 1024 * DFF; d.ldb = DFF; d.ssq_out = ssq + (size_t)(2 * l + 1) * M;
    }
  } else if (gi == 12 || gi == 18) {
    const bool fox = gi == 18;
    d.Bt = fox ? p.w_fqkvf : p.w_sbqkv; d.N = fox ? 3200 : 3072; d.epi = EPI_STORE; d.ssq_in = ssq + (size_t)(fox ? 5 : 1) * M;
    d.d0 = p.R; d.n0end = 1024; d.d1 = p.R + R_K_SB; d.n1end = 2048; d.vt = p.R + R_VT_SB; d.nvend = 3072;
    d.flog = p.flog; d.bfv = p.in[15]; d.kmax = fox ? (p.counters + 16) : nullptr;
  } else if (gi == 13 || gi == 19) {
    d.A = p.R; d.Bt = gi == 13 ? p.w_sbo : p.w_fo; d.ssq_out = ssq + (size_t)(gi == 13 ? 2 : 6) * M;
  } else if (gi == 14) {
    d.Bt = p.w_mdown; d.N = 768; d.epi = EPI_STORE; d.ssq_in = ssq + (size_t)3 * M;
    d.d0 = p.down; d.ld0 = 768; d.n0end = 768; d.n1end = 768; d.nvend = 768;
    d.ssq_a = ssq + (size_t)8 * M; d.ssq_a_end = 384; d.ssq_b = ssq + (size_t)9 * M; d.ssq_b_end = 640;
  } else if (gi == 15) {
    d.A = p.down; d.lda = 768; d.K = 384; d.Bt = p.w_muq; d.ldb = 384; d.N = 1536; d.epi = EPI_STORE;
    d.ssq_in = ssq + (size_t)8 * M; d.inv_dim = 1.f / 384;
    d.d0 = p.R; d.ld0 = 1536; d.n0end = 1536; d.n1end = 1536; d.nvend = 1536;
  } else if (gi == 16) {
    d.A = p.down + 384; d.lda = 768; d.K = 256; d.Bt = p.w_mukv; d.ldb = 256; d.N = 2048; d.epi = EPI_STORE;
    d.ssq_in = ssq + (size_t)9 * M; d.inv_dim = 1.f / 256;
    d.n0end = 0; d.d1 = p.R + R_K_MLA; d.n1end = 1024; d.vt = p.R + R_VT_MLA; d.nvend = 2048;
  } else {
    d.A = p.R; d.lda = 1536; d.a_cs = 96; d.Bt = p.w_mo; d.ssq_out = ssq + (size_t)4 * M;
  }
  return d;
}

template <int GI> DI void run_gemm(const Params& p, bf16_t* smem) { const GemmDesc d = make_desc(p, GI); if (PROBE_ON && p.probe & 1) gemm_phase(d, smem, p.dryv); gemm_phase(d, smem); }
DI void run_ffn(const Params& p, int l, bool down, bf16_t* smem) { const GemmDesc d = make_desc(p, 4 + 2 * l + (down ? 1 : 0)); if (PROBE_ON && p.probe & 2) gemm_phase(d, smem, p.dryv); if ((PROBE_ON && p.probe & 64) && !down) gemm_phase(d, smem, 0); if ((PROBE_ON && p.probe & 512) && !down) gemm_phase(d, smem, p.dryv); gemm_phase(d, smem); }

#define XB_TMO      128
#define XB_XCNT(j)  (256  + 64 * (j))
#define XB_XSUB(j)  (1280 + 64 * (j))
#define XB_XGEN(j)  (2304 + 64 * (j))
#define XB_TOP      3328
#define XB_TOPGEN   3392
#define XCD_BAR_WORDS 3456
#define XB_SPIN_CAP (1u << 18)
#define LAS __attribute__((address_space(3)))
DI unsigned xb_ld(unsigned* p)              { return __hip_atomic_load(p, __ATOMIC_RELAXED, __HIP_MEMORY_SCOPE_AGENT); }
DI unsigned xb_add(unsigned* p, unsigned v) { return __hip_atomic_fetch_add(p, v, __ATOMIC_RELAXED, __HIP_MEMORY_SCOPE_AGENT); }
#define XB_SPIN(cond, bar) do { unsigned _sp = 0; while (cond) { __builtin_amdgcn_s_sleep(1); \
    if ((++_sp & 255u) == 0u) { if (xb_ld(&(bar)[XB_TMO])) break; if (_sp > XB_SPIN_CAP) { atomicAdd(&(bar)[XB_TMO], 1u); break; } } } } while (0)
struct XcdBarrier { unsigned* bar; unsigned x; volatile LAS unsigned* st; };
DI XcdBarrier xcd_barrier_post(unsigned* bar, volatile LAS unsigned* st) {
  XcdBarrier b; b.bar = bar; b.x = xb_xcc_id(); b.st = st;
  if (threadIdx.x == 0) (void)xb_add(&bar[XB_XCNT(b.x)], 1u);
  return b;
}
DI void xcd_barrier_complete(unsigned* bar, unsigned x, unsigned& nloc, unsigned& nx) {
  const unsigned G = gridDim.x * gridDim.y * gridDim.z;
  unsigned sum, cnt, mine, sp = 0u;
  for (;;) {
    sum = 0u; cnt = 0u; mine = 0u;
#pragma unroll
    for (unsigned j = 0; j < 16; ++j) { const unsigned c = xb_ld(&bar[XB_XCNT(j)]); sum += c; cnt += (c > 0u) ? 1u : 0u; mine = (j == x) ? c : mine; }
    if (sum == G) break;
    __builtin_amdgcn_s_sleep(1);
    if ((++sp & 255u) == 0u) { if (xb_ld(&bar[XB_TMO])) break; if (sp > XB_SPIN_CAP) { atomicAdd(&bar[XB_TMO], 1u); break; } }
  }
  nloc = mine > 0u ? mine : 1u; nx = cnt > 0u ? cnt : 1u;
}
DI void xcd_barrier(const XcdBarrier& b) {
  asm volatile("s_waitcnt vmcnt(0)" ::: "memory");
  __syncthreads();
  if (threadIdx.x == 0) {
    unsigned* bar = b.bar;
    __builtin_amdgcn_s_waitcnt(0);
    unsigned nloc = b.st[0], nx = b.st[1];
    if (nloc == 0u) { xcd_barrier_complete(bar, b.x, nloc, nx); b.st[0] = nloc; b.st[1] = nx; }
    const unsigned old = xb_add(&bar[XB_XSUB(b.x)], 1u);
    const unsigned gen = old / nloc;
    if (old + 1u == (gen + 1u) * nloc) {
      __builtin_amdgcn_fence(__ATOMIC_RELEASE, "agent");
      asm volatile("s_waitcnt vmcnt(0)" ::: "memory");
      const unsigned og = xb_add(&bar[XB_TOP], 1u);
      const unsigned tg = og / nx;
      if (og + 1u == (tg + 1u) * nx) xb_add(&bar[XB_TOPGEN], 1u);
      else XB_SPIN(xb_ld(&bar[XB_TOPGEN]) == tg, bar);
      __builtin_amdgcn_fence(__ATOMIC_ACQUIRE, "agent");
      xb_add(&bar[XB_XGEN(b.x)], 1u);
      asm volatile("s_waitcnt vmcnt(0)" ::: "memory");
    } else {
      XB_SPIN(xb_ld(&bar[XB_XGEN(b.x)]) == gen, bar);
      __builtin_amdgcn_fence(__ATOMIC_ACQUIRE, "agent");
      asm volatile("s_waitcnt vmcnt(0)" ::: "memory");
    }
  }
  __syncthreads();
}
#define PHASE(body) { if (cur >= ph_begin && cur < ph_end) { body; if (cur + 1 < ph_end) { xcd_barrier(xb); if (PROBE_ON && p.probe & 256) { xcd_barrier(xb); xcd_barrier(xb); xcd_barrier(xb); xcd_barrier(xb); } } } ++cur; }

__global__ void __launch_bounds__(NTHREADS, 2) fwd_kernel(Params p, int ph_begin, int ph_end) {
  __shared__ __attribute__((aligned(16))) unsigned char smem_raw[SMEM_BYTES];
  bf16_t* smem = (bf16_t*)smem_raw;
  cg::grid_group grid = cg::this_grid();
  if (ph_begin < 0) grid.sync();
  __shared__ uint4 xb_words;
  if (threadIdx.x == 0) xb_words = make_uint4(0u, 0u, 0u, 0u);
  __syncthreads();
  XcdBarrier xb; xb.bar = p.bar; xb.x = 0; xb.st = (volatile LAS unsigned*)&xb_words;
  if (ph_end - ph_begin > 1) xb = xcd_barrier_post(p.bar, (volatile LAS unsigned*)&xb_words);
  int cur = 0;
  PHASE({
   for (int rep = (PROBE_ON && p.probe & 32) ? 0 : 1; rep < 2; ++rep) {
    for (int i = blockIdx.x * NTHREADS + threadIdx.x; i < 10 * M + 128; i += gridDim.x * NTHREADS) {
      if (i < 10 * M) p.ssq[i] = 0ull; else p.counters[i - 10 * M] = 0u;
    }
    for (int tile = blockIdx.x; tile < NB * (L / PT); tile += gridDim.x) pool_tile(p, tile, (float*)smem);
    for (int tile = blockIdx.x; tile < p.prep_tiles; tile += gridDim.x) {
      int ji = 0;
      _Pragma("unroll 1") for (int q = 1; q < NJOBS; ++q) if (tile >= p.jobs[q].tile_start) ji = q;
      prep_tile(p.jobs[ji], tile - p.jobs[ji].tile_start, (float*)smem);
    }
   }
  })
#pragma unroll 1
  for (int l = 0; l < 4; ++l) {
    if (l == 0) {
      PHASE({ run_gemm<0>(p, smem); })
    } else if (l == 1) {
      PHASE({ zero_vt_pad(p.R + R_VT_SB); run_gemm<12>(p, smem); })
      PHASE({
        AttnArgs aa; aa.q = p.R; aa.ldq = 1024; aa.hs = 64; aa.k = p.R + R_K_SB; aa.kr = nullptr; aa.vt = p.R + R_VT_SB; aa.Fh = nullptr; aa.ctr = p.counters + 80; aa.kmax = nullptr;
        if (PROBE_ON && p.probe & 4) { AttnArgs ab = aa; ab.ctr = p.counters + 104; attn_phase<0>(ab, smem, p.dryv); }
        attn_phase<0>(aa, smem);
      })
      PHASE({ run_gemm<13>(p, smem); })
    } else if (l == 2) {
      PHASE({ run_gemm<14>(p, smem); })
      PHASE({ zero_vt_pad(p.R + R_VT_MLA); kr_rope_phase(p); run_gemm<15>(p, smem); run_gemm<16>(p, smem); })
      PHASE({
        AttnArgs aa; aa.q = p.R; aa.ldq = 1536; aa.hs = 96; aa.k = p.R + R_K_MLA; aa.kr = p.kr; aa.vt = p.R + R_VT_MLA; aa.Fh = nullptr; aa.ctr = p.counters + 88; aa.kmax = nullptr;
        if (PROBE_ON && p.probe & 8) { AttnArgs ab = aa; ab.ctr = p.counters + 112; attn_phase<1>(ab, smem, p.dryv); }
        attn_phase<1>(aa, smem);
      })
      PHASE({ run_gemm<17>(p, smem); })
    } else {
      PHASE({ zero_vt_pad(p.R + R_VT_SB); run_gemm<18>(p, smem); })
      PHASE({ if (PROBE_ON && p.probe & 128) fox_scan_phase(p, (float*)smem); fox_scan_phase(p, (float*)smem); })
      PHASE({
        AttnArgs aa; aa.q = p.R; aa.ldq = 1024; aa.hs = 64; aa.k = p.R + R_K_SB; aa.kr = nullptr; aa.vt = p.R + R_VT_SB; aa.Fh = p.Fh; aa.ctr = p.counters + 96; aa.kmax = p.counters + 16;
        if (PROBE_ON && p.probe & 16) { AttnArgs ab = aa; ab.ctr = p.counters + 120; attn_phase<2>(ab, smem, p.dryv); }
        attn_phase<2>(aa, smem);
      })
      PHASE({ run_gemm<19>(p, smem); })
    }
    PHASE({ run_ffn(p, l, false, smem); })
    PHASE({ run_ffn(p, l, true, smem); })
  }
  PHASE({ if (PROBE_ON && p.probe & 128) final_phase(p); final_phase(p); })
}

static size_t align_up(size_t x) { return (x + 255) & ~(size_t)255; }

extern "C" void kernel_launch(void* const* d_in, const int* in_sizes, int n_in, void* d_out, int out_size, void* d_ws, size_t ws_size, hipStream_t stream) {
  (void)in_sizes; (void)n_in; (void)out_size; (void)ws_size;
  Params p;
  memset(&p, 0, sizeof(p));
  for (int i = 0; i < 21; ++i) p.in[i] = (const float*)d_in[i];
  p.out = (float*)d_out;
  unsigned char* ws = (unsigned char*)d_ws; size_t off = 0;
  auto take = [&](size_t bytes) { unsigned char* r = ws + off; off = align_up(off + bytes); return r; };
  p.w_pool = (bf16_t*)take((size_t)4 * 256 * 256 * 2);
  p.w_sbqkv = (bf16_t*)take((size_t)3072 * 1024 * 2);
  p.w_sbo = (bf16_t*)take((size_t)1024 * 1024 * 2);
  p.w_mdown = (bf16_t*)take((size_t)768 * 1024 * 2);
  p.w_muq = (bf16_t*)take((size_t)1536 * 384 * 2);
  p.w_mukv = (bf16_t*)take((size_t)2048 * 256 * 2);
  p.w_mo = (bf16_t*)take((size_t)1024 * 1024 * 2);
  p.w_fqkvf = (bf16_t*)take((size_t)3200 * 1024 * 2);
  p.w_fo = (bf16_t*)take((size_t)1024 * 1024 * 2);
  p.w_gu = (bf16_t*)take((size_t)4 * 5632 * 1024 * 2);
  p.w_dn = (bf16_t*)take((size_t)4 * 1024 * DFF * 2);
  p.h = nullptr;
  p.hb = (bf16_t*)take((size_t)M * D * 2);
  p.ssq = (u64*)take((size_t)10 * M * 8 + 512);
  p.counters = (unsigned*)(p.ssq + (size_t)10 * M);
  p.flog = (float*)take((size_t)M * 16 * 4);
  p.Fh = (float*)take((size_t)NB * NH * LP * 4);
  p.kr = (bf16_t*)take((size_t)M * 32 * 2);
  p.bar = (unsigned*)take(XCD_BAR_WORDS * 4);
  p.R = (bf16_t*)take((size_t)M * 2560 * 2 + (size_t)NB * NH * 64 * LP * 2);
  p.down = (bf16_t*)d_out;

  int nj = 0, tiles = 0;
  auto add = [&](const float* src, bf16_t* dst, const float* gain, const float* cs, int K, int Njob, int Npad, int ld_src, int ld_dst,
                 int sblk, int sstride, int soff, int dblk, int dstride, int doff) {
    PrepJob& j = p.jobs[nj++];
    j.src = src; j.dst = dst; j.gain = gain; j.colscale = cs; j.K = K; j.Njob = Njob; j.Npad = Npad; j.ld_src = ld_src; j.ld_dst = ld_dst;
    j.sblk = sblk; j.sstride = sstride; j.soff = soff; j.dblk = dblk; j.dstride = dstride; j.doff = doff;
    j.tile_start = tiles; j.ntn = (Npad + 63) / 64; tiles += (K / 64) * j.ntn;
  };
  const int BIG = 1 << 30;
  const float* nmix = p.in[2]; const float* nffn = p.in[3];
  for (int g = 0; g < 4; ++g)
    add(p.in[4] + (size_t)g * 65536, p.w_pool + (size_t)g * 65536, nullptr, p.in[5] + g * 256, 256, 256, 256, 256, 256, BIG, 0, 0, BIG, 0, 0);
  add(p.in[6], p.w_sbqkv, nmix + 1 * D, nullptr, 1024, 3072, 3072, 3072, 1024, BIG, 0, 0, BIG, 0, 0);
  add(p.in[7], p.w_sbo, nullptr, nullptr, 1024, 1024, 1024, 1024, 1024, BIG, 0, 0, BIG, 0, 0);
  add(p.in[8], p.w_mdown, nmix + 2 * D, nullptr, 1024, 672, 768, 672, 1024, BIG, 0, 0, BIG, 0, 0);
  add(p.in[11], p.w_muq, p.in[9], nullptr, 384, 1536, 1536, 1536, 384, BIG, 0, 0, BIG, 0, 0);
  add(p.in[12], p.w_mukv, p.in[10], nullptr, 256, 1024, 1024, 2048, 256, 64, 128, 0, BIG, 0, 0);
  add(p.in[12], p.w_mukv, p.in[10], nullptr, 256, 1024, 1024, 2048, 256, 64, 128, 64, BIG, 0, 1024);
  add(p.in[13], p.w_mo, nullptr, nullptr, 1024, 1024, 1024, 1024, 1024, BIG, 0, 0, BIG, 0, 0);
  add(p.in[14], p.w_fqkvf, nmix + 3 * D, nullptr, 1024, 3088, 3200, 3088, 1024, BIG, 0, 0, BIG, 0, 0);
  add(p.in[16], p.w_fo, nullptr, nullptr, 1024, 1024, 1024, 1024, 1024, BIG, 0, 0, BIG, 0, 0);
  for (int l = 0; l < 4; ++l) {
    add(p.in[17] + (size_t)l * 1024 * DFF, p.w_gu + (size_t)l * 5632 * 1024, nffn + l * D, nullptr, 1024, DFF, DFF, DFF, 1024, BIG, 0, 0, 32, 64, 0);
    add(p.in[18] + (size_t)l * 1024 * DFF, p.w_gu + (size_t)l * 5632 * 1024, nffn + l * D, nullptr, 1024, DFF, DFF, DFF, 1024, BIG, 0, 0, 32, 64, 32);
    add(p.in[19] + (size_t)l * DFF * 1024, p.w_dn + (size_t)l * 1024 * DFF, nullptr, nullptr, DFF, 1024, 1024, 1024, DFF, BIG, 0, 0, BIG, 0, 0);
  }
  p.prep_tiles = tiles;
#ifndef PROBE_MASK
#define PROBE_MASK 0
#endif
#ifndef DRYV
#define DRYV 1
#endif
  p.probe = PROBE_MASK; p.dryv = DRYV;

  static int grid_blocks = 0;
  if (!grid_blocks) {
    int dev = 0, cus = 0, per_cu = 0;
    (void)hipGetDevice(&dev);
    (void)hipDeviceGetAttribute(&cus, hipDeviceAttributeMultiprocessorCount, dev);
    (void)hipOccupancyMaxActiveBlocksPerMultiprocessor(&per_cu, fwd_kernel, NTHREADS, 0);
    if (per_cu > 2) per_cu = 2;
    if (per_cu < 1) per_cu = 1;
    grid_blocks = cus * per_cu;
  }
#ifndef MULTI_LAUNCH
#define MULTI_LAUNCH 0
#endif
#if MULTI_LAUNCH
  for (int ph = 0; ph < NPHASE; ++ph) {
    hipLaunchKernelGGL(fwd_kernel, dim3(grid_blocks), dim3(NTHREADS), 0, stream, p, ph, ph + 1);
  }
#else
  (void)hipMemsetAsync(p.bar, 0, XCD_BAR_WORDS * 4, stream);
  int b0 = 0, b1 = NPHASE;
  void* args[] = {&p, &b0, &b1};
  hipError_t e = hipLaunchCooperativeKernel((void*)fwd_kernel, dim3(grid_blocks), dim3(NTHREADS), args, 0, stream);
  if (e != hipSuccess) fprintf(stderr, "cooperative launch failed: %s (grid %d)\n", hipGetErrorString(e), grid_blocks);
#endif
}
```
